# Optimizing an MI355X kernel written in HIP

```python
import jax, jax.numpy as jnp
from jax import lax
import numpy as np

D_MODEL = 1024
BATCH = 32
SEQ = 256
DEPTH = 1
DEC_BATCH = 2
DEC_SEQ = 1024
PAST_LEN = 512

GRID_W = 64
D_A = 512
N_HEADS_A = 4
HEAD_A = D_A // N_HEADS_A
N_DIRS = 2
D_B = 512
N_POOL_GROUPS = 4
POOL_GROUP = D_B // N_POOL_GROUPS
POOL_WINDOWS = (2, 4, 8, 16)
D_FF = -(-8 * D_MODEL // (3 * 256)) * 256
CHUNK = 32
EPS = 1e-6
SPLITS = [D_A, 2 * D_A, 3 * D_A, 4 * D_A, 5 * D_A, 5 * D_A + D_B, 5 * D_A + D_B + D_MODEL]
IN_COLS = 5 * D_A + D_B + 2 * D_MODEL

kernel_name = 'hybrid_hgrn2_pool_prefix_dit_step'


def rmsnorm(x, g):
    x32 = x.astype(jnp.float32)
    y = x32 * lax.rsqrt(jnp.mean(x32 * x32, axis=-1, keepdims=True) + EPS)
    return (y * g.astype(jnp.float32)).astype(x.dtype)


def hgrn2_scan(q, k, v, logf, s0):
    B, T, H, _ = q.shape
    n = T // CHUNK

    def to_chunks(a):
        return a.astype(jnp.float32).reshape(B, n, CHUNK, H, a.shape[-1]).transpose(1, 0, 3, 2, 4)

    qc, kc, vc, gc = to_chunks(q), to_chunks(k), to_chunks(v), to_chunks(logf)
    lower = jnp.tril(jnp.ones((CHUNK, CHUNK), dtype=bool))[:, :, None]

    def step(S, inp):
        qt, kt, vt, gt = inp
        b = jnp.cumsum(gt, axis=-2)
        o_inter = jnp.einsum('bhtd,bhde->bhte', qt * jnp.exp(b), S)
        diff = b[:, :, :, None, :] - b[:, :, None, :, :]
        decay = jnp.exp(jnp.where(lower, diff, -jnp.inf))
        scores = jnp.einsum('bhtd,bhsd,bhtsd->bhts', qt, kt, decay)
        o_intra = jnp.einsum('bhts,bhse->bhte', scores, vt)
        b_last = b[:, :, -1, :]
        S_new = jnp.exp(b_last)[..., None] * S + jnp.einsum(
            'bhsd,bhse->bhde', kt * jnp.exp(b_last[:, :, None, :] - b), vt)
        return S_new, o_inter + o_intra

    S_fin, o = lax.scan(step, s0.astype(jnp.float32), (qc, kc, vc, gc))
    o = o.transpose(1, 0, 3, 2, 4).reshape(B, T, H, -1)
    return o, S_fin


def hgrn2_branch(zq, zf_fwd, zf_bwd, zi, zog, lb, norm_g, s0_fwd, s0_bwd):
    B, T, _ = zq.shape
    heads = lambda a: a.reshape(B, T, N_HEADS_A, HEAD_A)

    def gate(zf, lbd):
        f = lbd + (1.0 - lbd) * jax.nn.sigmoid(zf.astype(jnp.float32))
        return heads(jnp.log(f)), heads(1.0 - f)

    q, v = heads(zq), heads(zi)
    logf_f, k_f = gate(zf_fwd, lb[0])
    logf_b, k_b = gate(zf_bwd, lb[1])
    o_f, S_f = hgrn2_scan(q, k_f, v, logf_f, s0_fwd)
    flip = lambda a: jnp.flip(a, axis=1)
    o_b, S_b = hgrn2_scan(flip(q), flip(k_b), flip(v), flip(logf_b), s0_bwd)
    o = o_f + flip(o_b)
    o = o * lax.rsqrt(jnp.mean(o * o, axis=-1, keepdims=True) + EPS)
    o = o * norm_g.astype(jnp.float32).reshape(N_HEADS_A, HEAD_A)
    o = o.reshape(B, T, D_A) * jax.nn.silu(zog.astype(jnp.float32))
    return o.astype(zq.dtype), S_f, S_b


def pool_minus_self_1d(x):
    B, T, _ = x.shape
    x32 = x.astype(jnp.float32)
    cs = jnp.concatenate([jnp.zeros((B, 1, D_B), jnp.float32), jnp.cumsum(x32, axis=1)], axis=1)
    pos = jnp.arange(T)
    outs = []
    for g, w in enumerate(POOL_WINDOWS):
        lo = jnp.clip(pos - w // 2, 0, T - 1)
        hi = jnp.clip(pos + w // 2 - 1, 0, T - 1)
        csg = cs[..., g * POOL_GROUP:(g + 1) * POOL_GROUP]
        s = jnp.take(csg, hi + 1, axis=1) - jnp.take(csg, lo, axis=1)
        cnt = (hi - lo + 1).astype(jnp.float32)[None, :, None]
        outs.append(s / cnt)
    return (jnp.concatenate(outs, axis=-1) - x32).astype(x.dtype)


def pool_minus_self_2d(x):
    B, T, _ = x.shape
    rows = T // GRID_W
    xg = x.astype(jnp.float32).reshape(B, rows, GRID_W, D_B)
    sat = jnp.pad(jnp.cumsum(jnp.cumsum(xg, axis=1), axis=2), ((0, 0), (1, 0), (1, 0), (0, 0)))
    r, cidx = jnp.arange(rows), jnp.arange(GRID_W)
    outs = []
    for g, w in enumerate(POOL_WINDOWS):
        rlo, rhi = jnp.clip(r - w // 2, 0, rows - 1), jnp.clip(r + w // 2 - 1, 0, rows - 1)
        clo, chi = jnp.clip(cidx - w // 2, 0, GRID_W - 1), jnp.clip(cidx + w // 2 - 1, 0, GRID_W - 1)
        sg = sat[..., g * POOL_GROUP:(g + 1) * POOL_GROUP]
        rect = lambda ri, ci: jnp.take(jnp.take(sg, ri, axis=1), ci, axis=2)
        s = rect(rhi + 1, chi + 1) - rect(rlo, chi + 1) - rect(rhi + 1, clo) + rect(rlo, clo)
        cnt = ((rhi - rlo + 1)[:, None] * (chi - clo + 1)[None, :]).astype(jnp.float32)
        outs.append(s / cnt[None, :, :, None])
    pooled = jnp.concatenate(outs, axis=-1)
    return (pooled - xg).reshape(B, T, D_B).astype(x.dtype)


def trunk_layer(x, mod, s0_fwd, s0_bwd, grid, lb, norm1_g, w_in, hgrn_norm_g, w_branch_a,
                pool_w, pool_scale, w_branch_b, w_out, norm2_g, w_ffn_in, w_ffn_out):
    B, T, _ = x.shape
    shift1, scale1, gate1, shift2, scale2, gate2 = [m[:, None, :] for m in jnp.split(mod, 6, axis=-1)]
    h = rmsnorm(x, norm1_g) * (1.0 + scale1) + shift1
    zq, zf_fwd, zf_bwd, zi, zog, zpool, zga, zgb = jnp.split(h @ w_in, SPLITS, axis=-1)
    o_a, S_f, S_b = hgrn2_branch(zq, zf_fwd, zf_bwd, zi, zog, lb, hgrn_norm_g, s0_fwd, s0_bwd)
    pm = pool_minus_self_2d(zpool) if grid else pool_minus_self_1d(zpool)
    o_b = jnp.einsum('btgc,gcd->btgd', pm.reshape(B, T, N_POOL_GROUPS, POOL_GROUP), pool_w)
    o_b = o_b.reshape(B, T, D_B) * pool_scale
    merged = jax.nn.sigmoid(zga) * (o_a @ w_branch_a) + jax.nn.sigmoid(zgb) * (o_b @ w_branch_b)
    x = x + gate1 * (merged @ w_out)
    h2 = rmsnorm(x, norm2_g) * (1.0 + scale2) + shift2
    g_part, u_part = jnp.split(h2 @ w_ffn_in, 2, axis=-1)
    x = x + gate2 * ((jax.nn.silu(g_part) * u_part) @ w_ffn_out)
    return x, S_f, S_b


def setup_inputs(seed: int = 0) -> dict:
    key = jax.random.key(seed)
    ks = jax.random.split(key, 20)
    nrm = lambda k, shape, scale: jax.random.normal(k, shape, jnp.float32) * scale
    return {
        'x_prompt': nrm(ks[0], (BATCH, SEQ, D_MODEL), 1.0),
        'x_sample': nrm(ks[1], (DEC_BATCH, DEC_SEQ, D_MODEL), 1.0),
        'state_hgrn': nrm(ks[2], (DEC_BATCH, DEPTH, N_DIRS, N_HEADS_A, HEAD_A, HEAD_A), 0.5),
        'c': nrm(ks[3], (DEC_BATCH, D_MODEL), 1.0),
        'c_ctx': nrm(ks[4], (D_MODEL,), 1.0),
        'w_ada': nrm(ks[5], (DEPTH, D_MODEL, 6 * D_MODEL), D_MODEL ** -0.5),
        'b_ada': nrm(ks[6], (DEPTH, 6 * D_MODEL), 0.02),
        'norm1_g': 1.0 + nrm(ks[7], (DEPTH, D_MODEL), 0.05),
        'w_in': nrm(ks[8], (DEPTH, D_MODEL, IN_COLS), D_MODEL ** -0.5),
        'hgrn_lb_logits': nrm(ks[9], (DEPTH + 1, N_DIRS, D_A), 0.5),
        'hgrn_norm_g': 1.0 + nrm(ks[10], (DEPTH, D_A), 0.05),
        'w_branch_a': nrm(ks[11], (DEPTH, D_A, D_MODEL), D_A ** -0.5),
        'pool_w': nrm(ks[12], (DEPTH, N_POOL_GROUPS, POOL_GROUP, POOL_GROUP), POOL_GROUP ** -0.5),
        'pool_scale': 1.0 + nrm(ks[13], (DEPTH, D_B), 0.05),
        'w_branch_b': nrm(ks[14], (DEPTH, D_B, D_MODEL), D_B ** -0.5),
        'w_out': nrm(ks[15], (DEPTH, D_MODEL, D_MODEL), D_MODEL ** -0.5),
        'norm2_g': 1.0 + nrm(ks[16], (DEPTH, D_MODEL), 0.05),
        'w_ffn_in': nrm(ks[17], (DEPTH, D_MODEL, 2 * D_FF), D_MODEL ** -0.5),
        'w_ffn_out': nrm(ks[18], (DEPTH, D_FF, D_MODEL), D_FF ** -0.5),
        'final_g': 1.0 + nrm(ks[19], (D_MODEL,), 0.05),
    }


def reference(x_prompt, x_sample, state_hgrn, c, c_ctx, w_ada, b_ada, norm1_g, w_in,
              hgrn_lb_logits, hgrn_norm_g, w_branch_a, pool_w, pool_scale, w_branch_b,
              w_out, norm2_g, w_ffn_in, w_ffn_out, final_g):
    lb_all = jnp.cumsum(jax.nn.softmax(hgrn_lb_logits.astype(jnp.float32), axis=0), axis=0)
    B_p = x_prompt.shape[0]
    zeros_state = jnp.zeros((B_p, N_HEADS_A, HEAD_A, HEAD_A), jnp.float32)
    xp, xs = x_prompt, x_sample
    ctx_states = []
    for l in range(DEPTH):
        layer_w = (lb_all[l], norm1_g[l], w_in[l], hgrn_norm_g[l], w_branch_a[l], pool_w[l],
                   pool_scale[l], w_branch_b[l], w_out[l], norm2_g[l], w_ffn_in[l], w_ffn_out[l])
        mod_ctx = jax.nn.silu(c_ctx[None, :]) @ w_ada[l] + b_ada[l]
        mod_lat = jax.nn.silu(c) @ w_ada[l] + b_ada[l]
        xp, S_f, S_b = trunk_layer(xp, mod_ctx, zeros_state, zeros_state, False, *layer_w)
        ctx_states.append(jnp.stack([S_f, S_b], axis=1))
        xs, _, _ = trunk_layer(xs, mod_lat, state_hgrn[:, l, 0], state_hgrn[:, l, 1], True, *layer_w)
    y_prompt = rmsnorm(xp, final_g)
    y_sample = rmsnorm(xs, final_g)
    new_state_hgrn = jnp.stack(ctx_states, axis=1).astype(x_prompt.dtype)
    return (y_prompt, y_sample, new_state_hgrn)
```

```cpp
#include <hip/hip_runtime.h>
#include <stdint.h>
#include <stdio.h>

typedef unsigned short bf16_t;
typedef short bf16x8 __attribute__((ext_vector_type(8)));
typedef float f32x4 __attribute__((ext_vector_type(4)));

constexpr int D = 1024;
constexpr int BC = 32, TC = 256, BL = 2, TL = 1024;
constexpr int NCTX = BC * TC, NLAT = BL * TL, M = NCTX + NLAT;
constexpr int DA = 512, NH = 4, HD = 128, DB = 512;
constexpr int INC = 5120, DFF = 2816, NFF2 = 2 * DFF;
constexpr int MODW = 6 * D;
constexpr int GRID_W = 64, GRID_H = TL / GRID_W;
constexpr float EPS = 1e-6f;

constexpr size_t MiB = 1u << 20;
constexpr size_t WS_CTL = 0;
constexpr size_t WS_MOD = 1 * MiB;
constexpr size_t WS_BIAS2 = 1 * MiB + 128 * 1024;
constexpr size_t WS_WIN = 2 * MiB;
constexpr size_t WS_WCAT = 12 * MiB;
constexpr size_t WS_WOUT = 14 * MiB;
constexpr size_t WS_WFFI = 16 * MiB;
constexpr size_t WS_WFFO = 27 * MiB;
constexpr size_t WS_H1 = 34 * MiB;
constexpr size_t WS_Q = 54 * MiB, WS_V = 64 * MiB, WS_OG = 74 * MiB, WS_POOL = 84 * MiB;
constexpr size_t WS_GA = 94 * MiB, WS_GB = 114 * MiB;
constexpr size_t WS_LOGF = 134 * MiB;
constexpr size_t WS_KK = 174 * MiB;
constexpr size_t WS_OTMP = 194 * MiB;
constexpr size_t WS_SS2 = 194 * MiB;
constexpr size_t WS_ACAT = 214 * MiB;
constexpr size_t WS_MERGED = 234 * MiB;
constexpr size_t WS_X1 = WS_LOGF;
constexpr size_t WS_A2 = WS_H1;
constexpr size_t WS_ACT = WS_Q;
constexpr size_t WS_END = 254 * MiB;

__device__ __forceinline__ float bf2f(bf16_t b) { return __uint_as_float(((unsigned)b) << 16); }
__device__ __forceinline__ bf16_t f2bf(float f) { unsigned u = __float_as_uint(f); u += 0x7fffu + ((u >> 16) & 1u); return (bf16_t)(u >> 16); }
__device__ __forceinline__ float sigmoidf_(float z) { return 1.0f / (1.0f + __expf(-z)); }
__device__ __forceinline__ int grp_of_row(int m) { return m < NCTX ? 0 : 1 + (m - NCTX) / TL; }
__device__ __forceinline__ float wave_sum(float v) {
#pragma unroll
    for (int o = 1; o < 64; o <<= 1) v += __shfl_xor(v, o);
    return v;
}

struct Ptrs {
    const float* x_prompt; const float* x_sample; const float* state; const float* c; const float* c_ctx; const float* w_ada; const float* b_ada;
    const float* norm1_g; const float* w_in; const float* lb_logits; const float* hgrn_norm_g; const float* w_branch_a; const float* pool_w;
    const float* pool_scale; const float* w_branch_b; const float* w_out; const float* norm2_g; const float* w_ffn_in; const float* w_ffn_out; const float* final_g;
    float* out; unsigned char* ws;
};
__device__ __forceinline__ const float* xrow(const Ptrs& P, int m) { return m < NCTX ? P.x_prompt + (size_t)m * D : P.x_sample + (size_t)(m - NCTX) * D; }

__global__ void ks_mod(Ptrs P) {
    const int i = blockIdx.x * blockDim.x + threadIdx.x; if (i >= 3 * MODW) return;
    const int g = i / MODW, n = i % MODW; const float* cv = g == 0 ? P.c_ctx : P.c + (size_t)(g - 1) * D;
    float s = 0.f;
    for (int k = 0; k < D; ++k) { const float c = cv[k]; s += (c * sigmoidf_(c)) * P.w_ada[(size_t)k * MODW + n]; }
    ((float*)(P.ws + WS_MOD))[i] = s + P.b_ada[n];
}
__global__ void ks_convT(const float* src, int K, int N, bf16_t* dst, int ldd, int koff, int mode) {
    const size_t i = (size_t)blockIdx.x * blockDim.x + threadIdx.x; if (i >= (size_t)K * N) return;
    const int k = (int)(i / N), n = (int)(i % N);
    int r = n;
    if (mode == 1) { const int j = n < DFF ? n : n - DFF; r = (j / 128) * 256 + (j % 128) + (n < DFF ? 0 : 128); }
    dst[(size_t)r * ldd + koff + k] = f2bf(src[i]);
}
__global__ void ks_wpb(Ptrs P) {
    const int i = blockIdx.x * blockDim.x + threadIdx.x; if (i >= DB * D) return;
    const int gc = i / D, n = i % D, g = gc / 128;
    float s = 0.f;
    for (int d = 0; d < 128; ++d) s += P.pool_w[(size_t)gc * 128 + d] * P.pool_scale[g * 128 + d] * P.w_branch_b[(size_t)(g * 128 + d) * D + n];
    ((bf16_t*)(P.ws + WS_WCAT))[(size_t)n * 1024 + 512 + gc] = f2bf(s);
}
__global__ void ks_h1(Ptrs P) {
    const int m = (blockIdx.x * blockDim.x + threadIdx.x) >> 6, lane = threadIdx.x & 63; if (m >= M) return;
    const float* xr = xrow(P, m); const float* mod = (const float*)(P.ws + WS_MOD) + (size_t)grp_of_row(m) * MODW;
    float ss = 0.f; for (int k = lane; k < D; k += 64) { const float v = xr[k]; ss += v * v; }
    const float rstd = rsqrtf(wave_sum(ss) * (1.0f / D) + EPS);
    bf16_t* h = (bf16_t*)(P.ws + WS_H1) + (size_t)m * D;
    for (int k = lane; k < D; k += 64) h[k] = f2bf((xr[k] * rstd * P.norm1_g[k]) * (1.0f + mod[D + k]) + mod[k]);
}
__global__ void ks_bias2(Ptrs P) {
    const int i = blockIdx.x * blockDim.x + threadIdx.x; if (i >= 3 * NFF2) return;
    const int g = i / NFF2, n = i % NFF2; const float* sh = (const float*)(P.ws + WS_MOD) + (size_t)g * MODW + 3 * D;
    const bf16_t* w = (const bf16_t*)(P.ws + WS_WFFI) + (size_t)n * D; float s = 0.f;
    for (int k = 0; k < D; ++k) s += sh[k] * bf2f(w[k]);
    ((float*)(P.ws + WS_BIAS2))[i] = s;
}

template <class Epi>
__global__ __launch_bounds__(256) void ks_gemm(const bf16_t* A, int lda, const bf16_t* Bt, int ldb, int K, int Mrows, int Nout, Epi E) {
    const int wave = (blockIdx.x * 256 + threadIdx.x) >> 6, lane = threadIdx.x & 63, row = lane & 15, quad = lane >> 4;
    const int tn_count = Nout / 32, tm = wave / tn_count, tn = wave % tn_count; if (tm >= Mrows / 32) return;
    const int j0 = tn * 32, b1 = Epi::brow1(j0), b2 = Epi::brow2(j0);
    f32x4 acc1[2][2], acc2[2][2];
#pragma unroll
    for (int i = 0; i < 2; ++i)
#pragma unroll
        for (int j = 0; j < 2; ++j) { acc1[i][j] = (f32x4){0.f, 0.f, 0.f, 0.f}; acc2[i][j] = (f32x4){0.f, 0.f, 0.f, 0.f}; }
    for (int k0 = 0; k0 < K; k0 += 32) {
        bf16x8 a[2], b[2];
#pragma unroll
        for (int i = 0; i < 2; ++i) a[i] = *(const bf16x8*)(A + (size_t)(tm * 32 + i * 16 + row) * lda + k0 + quad * 8);
#pragma unroll
        for (int j = 0; j < 2; ++j) b[j] = *(const bf16x8*)(Bt + (size_t)(b1 + j * 16 + row) * ldb + k0 + quad * 8);
#pragma unroll
        for (int i = 0; i < 2; ++i)
#pragma unroll
            for (int j = 0; j < 2; ++j) acc1[i][j] = __builtin_amdgcn_mfma_f32_16x16x32_bf16(a[i], b[j], acc1[i][j], 0, 0, 0);
        if (Epi::DUAL) {
#pragma unroll
            for (int i = 0; i < 2; ++i) a[i] = *(const bf16x8*)(A + (size_t)(tm * 32 + i * 16 + row) * lda + Epi::KOFF2 + k0 + quad * 8);
#pragma unroll
            for (int j = 0; j < 2; ++j) b[j] = *(const bf16x8*)(Bt + (size_t)(b2 + j * 16 + row) * ldb + Epi::KOFF2 + k0 + quad * 8);
#pragma unroll
            for (int i = 0; i < 2; ++i)
#pragma unroll
                for (int j = 0; j < 2; ++j) acc2[i][j] = __builtin_amdgcn_mfma_f32_16x16x32_bf16(a[i], b[j], acc2[i][j], 0, 0, 0);
        }
    }
#pragma unroll
    for (int i = 0; i < 2; ++i)
#pragma unroll
        for (int j = 0; j < 2; ++j)
#pragma unroll
            for (int r = 0; r < 4; ++r) E(tm * 32 + i * 16 + quad * 4 + r, j0 + j * 16 + row, acc1[i][j][r], acc2[i][j][r]);
}

struct EpiG1s {
    static constexpr bool DUAL = false; static constexpr int KOFF2 = 0;
    static __device__ __forceinline__ int brow1(int j0) { return j0; }
    static __device__ __forceinline__ int brow2(int j0) { return j0; }
    unsigned char* ws; const float* lbl;
    __device__ __forceinline__ void operator()(int m, int n, float v, float) const {
        if (n < 512) ((bf16_t*)(ws + WS_Q))[(size_t)m * 512 + n] = f2bf(v);
        else if (n < 1536) {
            const int dd = n - 512;
            const float lb = sigmoidf_(lbl[dd] - lbl[1024 + dd]);
            const float e = __expf(-v), sig = 1.0f / (1.0f + e), f = lb + (1.0f - lb) * sig;
            ((float*)(ws + WS_LOGF))[(size_t)m * 1024 + dd] = __logf(f);
            ((bf16_t*)(ws + WS_KK))[(size_t)m * 1024 + dd] = f2bf((1.0f - lb) * e * sig);
        }
        else if (n < 2048) ((bf16_t*)(ws + WS_V))[(size_t)m * 512 + n - 1536] = f2bf(v);
        else if (n < 2560) ((bf16_t*)(ws + WS_OG))[(size_t)m * 512 + n - 2048] = f2bf(v * sigmoidf_(v));
        else if (n < 3072) ((bf16_t*)(ws + WS_POOL))[(size_t)m * 512 + n - 2560] = f2bf(v);
        else if (n < 4096) ((bf16_t*)(ws + WS_GA))[(size_t)m * 1024 + n - 3072] = f2bf(sigmoidf_(v));
        else ((bf16_t*)(ws + WS_GB))[(size_t)m * 1024 + n - 4096] = f2bf(sigmoidf_(v));
    }
};
struct EpiMerges {
    static constexpr bool DUAL = true; static constexpr int KOFF2 = 512;
    static __device__ __forceinline__ int brow1(int j0) { return j0; }
    static __device__ __forceinline__ int brow2(int j0) { return j0; }
    unsigned char* ws;
    __device__ __forceinline__ void operator()(int m, int n, float v1, float v2) const {
        const float ga = bf2f(((const bf16_t*)(ws + WS_GA))[(size_t)m * 1024 + n]), gb = bf2f(((const bf16_t*)(ws + WS_GB))[(size_t)m * 1024 + n]);
        ((bf16_t*)(ws + WS_MERGED))[(size_t)m * 1024 + n] = f2bf(ga * v1 + gb * v2);
    }
};
struct EpiWouts {
    static constexpr bool DUAL = false; static constexpr int KOFF2 = 0;
    static __device__ __forceinline__ int brow1(int j0) { return j0; }
    static __device__ __forceinline__ int brow2(int j0) { return j0; }
    Ptrs P;
    __device__ __forceinline__ void operator()(int m, int n, float v, float) const {
        const float* mod = (const float*)(P.ws + WS_MOD) + (size_t)grp_of_row(m) * MODW;
        const float x1 = xrow(P, m)[n] + mod[2 * D + n] * v;
        ((float*)(P.ws + WS_X1))[(size_t)m * D + n] = x1;
        ((bf16_t*)(P.ws + WS_A2))[(size_t)m * D + n] = f2bf(x1 * P.norm2_g[n] * (1.0f + mod[4 * D + n]));
    }
};
__global__ void ks_ss2(Ptrs P) {
    const int i = blockIdx.x * blockDim.x + threadIdx.x; if (i >= M * 16) return;
    const float* x1 = (const float*)(P.ws + WS_X1) + (size_t)(i / 16) * D + (i % 16) * 64; float s = 0.f;
    for (int k = 0; k < 64; ++k) s += x1[k] * x1[k];
    ((float*)(P.ws + WS_SS2))[i] = s;
}
struct EpiFfnIns {
    static constexpr bool DUAL = true; static constexpr int KOFF2 = 0;
    static __device__ __forceinline__ int brow1(int j0) { return (j0 / 128) * 256 + (j0 % 128); }
    static __device__ __forceinline__ int brow2(int j0) { return (j0 / 128) * 256 + (j0 % 128) + 128; }
    unsigned char* ws;
    __device__ __forceinline__ void operator()(int m, int j, float v1, float v2) const {
        const float* ss = (const float*)(ws + WS_SS2) + (size_t)m * 16; float s = 0.f;
        for (int p = 0; p < 16; ++p) s += ss[p];
        const float rstd = rsqrtf(s * (1.0f / D) + EPS);
        const float* b2 = (const float*)(ws + WS_BIAS2) + (size_t)grp_of_row(m) * NFF2; const int n1 = (j / 128) * 256 + (j % 128);
        const float gv = v1 * rstd + b2[n1], uv = v2 * rstd + b2[n1 + 128];
        ((bf16_t*)(ws + WS_ACT))[(size_t)m * DFF + j] = f2bf(gv * sigmoidf_(gv) * uv);
    }
};
struct EpiFfnOuts {
    static constexpr bool DUAL = false; static constexpr int KOFF2 = 0;
    static __device__ __forceinline__ int brow1(int j0) { return j0; }
    static __device__ __forceinline__ int brow2(int j0) { return j0; }
    Ptrs P;
    __device__ __forceinline__ void operator()(int m, int n, float v, float) const {
        const float* mod = (const float*)(P.ws + WS_MOD) + (size_t)grp_of_row(m) * MODW;
        P.out[(size_t)m * D + n] = ((const float*)(P.ws + WS_X1))[(size_t)m * D + n] + mod[5 * D + n] * v;
    }
};
__global__ void ks_final(Ptrs P) {
    const int m = (blockIdx.x * blockDim.x + threadIdx.x) >> 6, lane = threadIdx.x & 63; if (m >= M) return;
    float* xr = P.out + (size_t)m * D; float v[16]; float ss = 0.f;
#pragma unroll
    for (int i = 0; i < 16; ++i) { v[i] = xr[lane + 64 * i]; ss += v[i] * v[i]; }
    const float rstd = rsqrtf(wave_sum(ss) * (1.0f / D) + EPS);
#pragma unroll
    for (int i = 0; i < 16; ++i) xr[lane + 64 * i] = v[i] * rstd * P.final_g[lane + 64 * i];
}

__global__ __launch_bounds__(128) void ks_scan(Ptrs P, float* ofwd, float* obwd) {
    __shared__ float fl[128], kl[128], ql[128];
    const int u = blockIdx.x, e = threadIdx.x;
    int b, h, dir, T, row0; const bool ctx = u < BC * NH * 2;
    if (ctx) { b = u / 8; h = (u >> 1) & 3; dir = u & 1; T = TC; row0 = b * TC; }
    else { const int v = u - BC * NH * 2; b = v / 8; h = (v >> 1) & 3; dir = v & 1; T = TL; row0 = NCTX + b * TL; }
    float S[128];
#pragma unroll
    for (int d = 0; d < 128; ++d) S[d] = ctx ? 0.f : P.state[((size_t)((b * 2 + dir) * 4 + h) * 128 + d) * 128 + e];
    const float* LOGF = (const float*)(P.ws + WS_LOGF); const bf16_t* KK = (const bf16_t*)(P.ws + WS_KK);
    const bf16_t* Q = (const bf16_t*)(P.ws + WS_Q); const bf16_t* V = (const bf16_t*)(P.ws + WS_V);
    float* o_out = dir ? obwd : ofwd;
    for (int step = 0; step < T; ++step) {
        const int t = dir ? T - 1 - step : step; const size_t row = (size_t)(row0 + t);
        fl[e] = __expf(LOGF[row * 1024 + dir * 512 + h * 128 + e]); kl[e] = bf2f(KK[row * 1024 + dir * 512 + h * 128 + e]); ql[e] = bf2f(Q[row * 512 + h * 128 + e]);
        const float v = bf2f(V[row * 512 + h * 128 + e]);
        __syncthreads();
        float o = 0.f;
#pragma unroll
        for (int d = 0; d < 128; ++d) { S[d] = fl[d] * S[d] + kl[d] * v; o += ql[d] * S[d]; }
        __syncthreads();
        o_out[row * 512 + h * 128 + e] = o;
    }
    if (ctx) {
        float* ns = P.out + (size_t)M * D + (size_t)((b * 2 + dir) * 4 + h) * 128 * 128;
#pragma unroll
        for (int d = 0; d < 128; ++d) ns[(size_t)d * 128 + e] = S[d];
    }
}
__global__ void ks_ofinal(Ptrs P, const float* ofwd, const float* obwd) {
    const int w = (blockIdx.x * blockDim.x + threadIdx.x) >> 6, lane = threadIdx.x & 63; if (w >= M * NH) return;
    const int m = w / NH, h = w % NH; const size_t base = (size_t)m * 512 + h * 128;
    const float o0 = ofwd[base + lane] + obwd[base + lane], o1 = ofwd[base + 64 + lane] + obwd[base + 64 + lane];
    const float r = rsqrtf(wave_sum(o0 * o0 + o1 * o1) * (1.0f / 128.0f) + EPS);
    const bf16_t* og = (const bf16_t*)(P.ws + WS_OG) + base; bf16_t* dst = (bf16_t*)(P.ws + WS_ACAT) + (size_t)m * 1024 + h * 128;
    dst[lane] = f2bf(o0 * r * P.hgrn_norm_g[h * 128 + lane] * bf2f(og[lane]));
    dst[64 + lane] = f2bf(o1 * r * P.hgrn_norm_g[h * 128 + 64 + lane] * bf2f(og[64 + lane]));
}
__global__ void ks_pool(Ptrs P) {
    const int i = blockIdx.x * blockDim.x + threadIdx.x; if (i >= M * DB) return;
    const int m = i / DB, c = i % DB, w = 2 << (c / 128); const bf16_t* Z = (const bf16_t*)(P.ws + WS_POOL);
    float s = 0.f; int cnt;
    if (m < NCTX) {
        const int b = m / TC, pos = m % TC; int lo = pos - w / 2, hi = pos + w / 2 - 1; lo = lo < 0 ? 0 : lo; hi = hi > TC - 1 ? TC - 1 : hi;
        for (int t = lo; t <= hi; ++t) s += bf2f(Z[(size_t)(b * TC + t) * DB + c]);
        cnt = hi - lo + 1;
    } else {
        const int ml = m - NCTX, b = ml / TL, t = ml % TL, r = t / GRID_W, cc = t % GRID_W;
        int rlo = r - w / 2, rhi = r + w / 2 - 1, clo = cc - w / 2, chi = cc + w / 2 - 1;
        rlo = rlo < 0 ? 0 : rlo; rhi = rhi > GRID_H - 1 ? GRID_H - 1 : rhi; clo = clo < 0 ? 0 : clo; chi = chi > GRID_W - 1 ? GRID_W - 1 : chi;
        for (int rr = rlo; rr <= rhi; ++rr) for (int c2 = clo; c2 <= chi; ++c2) s += bf2f(Z[(size_t)(NCTX + b * TL + rr * GRID_W + c2) * DB + c]);
        cnt = (rhi - rlo + 1) * (chi - clo + 1);
    }
    ((bf16_t*)(P.ws + WS_ACAT))[(size_t)m * 1024 + 512 + c] = f2bf(s / (float)cnt - bf2f(Z[(size_t)m * DB + c]));
}

extern "C" void kernel_launch(void* const* d_in, const int* in_sizes, int n_in, void* d_out, int out_size, void* d_ws, size_t ws_size, hipStream_t stream) {
    if (n_in != 20 || ws_size < WS_END) { fprintf(stderr, "kernel_launch: unexpected n_in %d / ws %zu\n", n_in, ws_size); return; }
    Ptrs P{};
    const float** pp = (const float**)&P;
    for (int i = 0; i < 20; ++i) pp[i] = (const float*)d_in[i];
    P.out = (float*)d_out; P.ws = (unsigned char*)d_ws;
    unsigned char* ws = P.ws;
    auto nb = [](size_t n, int t) { return (unsigned)((n + t - 1) / t); };
    ks_mod<<<nb(3 * MODW, 256), 256, 0, stream>>>(P);
    ks_convT<<<nb((size_t)D * INC, 256), 256, 0, stream>>>(P.w_in, D, INC, (bf16_t*)(ws + WS_WIN), D, 0, 0);
    ks_convT<<<nb((size_t)DA * D, 256), 256, 0, stream>>>(P.w_branch_a, DA, D, (bf16_t*)(ws + WS_WCAT), 1024, 0, 0);
    ks_wpb<<<nb((size_t)DB * D, 256), 256, 0, stream>>>(P);
    ks_convT<<<nb((size_t)D * D, 256), 256, 0, stream>>>(P.w_out, D, D, (bf16_t*)(ws + WS_WOUT), D, 0, 0);
    ks_convT<<<nb((size_t)D * NFF2, 256), 256, 0, stream>>>(P.w_ffn_in, D, NFF2, (bf16_t*)(ws + WS_WFFI), D, 0, 1);
    ks_convT<<<nb((size_t)DFF * D, 256), 256, 0, stream>>>(P.w_ffn_out, DFF, D, (bf16_t*)(ws + WS_WFFO), DFF, 0, 0);
    ks_h1<<<nb((size_t)M * 64, 256), 256, 0, stream>>>(P);
    ks_bias2<<<nb(3 * NFF2, 256), 256, 0, stream>>>(P);
    ks_gemm<EpiG1s><<<nb((size_t)(M / 32) * (INC / 32) * 64, 256), 256, 0, stream>>>((const bf16_t*)(ws + WS_H1), D, (const bf16_t*)(ws + WS_WIN), D, D, M, INC, EpiG1s{ws, P.lb_logits});
    float* ofwd = (float*)(ws + WS_OTMP); float* obwd = (float*)(ws + WS_MERGED);
    ks_scan<<<BC * NH * 2 + BL * NH * 2, 128, 0, stream>>>(P, ofwd, obwd);
    ks_ofinal<<<nb((size_t)M * NH * 64, 256), 256, 0, stream>>>(P, ofwd, obwd);
    ks_pool<<<nb((size_t)M * DB, 256), 256, 0, stream>>>(P);
    ks_gemm<EpiMerges><<<nb((size_t)(M / 32) * (D / 32) * 64, 256), 256, 0, stream>>>((const bf16_t*)(ws + WS_ACAT), 1024, (const bf16_t*)(ws + WS_WCAT), 1024, 512, M, D, EpiMerges{ws});
    ks_gemm<EpiWouts><<<nb((size_t)(M / 32) * (D / 32) * 64, 256), 256, 0, stream>>>((const bf16_t*)(ws + WS_MERGED), 1024, (const bf16_t*)(ws + WS_WOUT), 1024, D, M, D, EpiWouts{P});
    ks_ss2<<<nb((size_t)M * 16, 256), 256, 0, stream>>>(P);
    ks_gemm<EpiFfnIns><<<nb((size_t)(M / 32) * (DFF / 32) * 64, 256), 256, 0, stream>>>((const bf16_t*)(ws + WS_A2), 1024, (const bf16_t*)(ws + WS_WFFI), 1024, D, M, DFF, EpiFfnIns{ws});
    ks_gemm<EpiFfnOuts><<<nb((size_t)(M / 32) * (D / 32) * 64, 256), 256, 0, stream>>>((const bf16_t*)(ws + WS_ACT), DFF, (const bf16_t*)(ws + WS_WFFO), DFF, DFF, M, D, EpiFfnOuts{P});
    ks_final<<<nb((size_t)M * 64, 256), 256, 0, stream>>>(P);
}
```

```cpp
#include <hip/hip_runtime.h>
#include <stdint.h>
#include <stdio.h>

typedef unsigned short bf16_t;
typedef short bf16x8 __attribute__((ext_vector_type(8)));
typedef float f32x4 __attribute__((ext_vector_type(4)));

constexpr int D = 1024;
constexpr int BC = 32, TC = 256, BL = 2, TL = 1024;
constexpr int NCTX = BC * TC, NLAT = BL * TL, M = NCTX + NLAT;
constexpr int DA = 512, NH = 4, HD = 128, DB = 512;
constexpr int INC = 5120, DFF = 2816, NFF2 = 2 * DFF;
constexpr int MODW = 6 * D;
constexpr int GRID_W = 64, GRID_H = TL / GRID_W;
constexpr float EPS = 1e-6f;

constexpr size_t MiB = 1u << 20;
constexpr size_t WS_CTL = 0;
constexpr size_t WS_MOD = 1 * MiB;
constexpr size_t WS_BIAS2 = 1 * MiB + 128 * 1024;
constexpr size_t WS_WIN = 2 * MiB;
constexpr size_t WS_WCAT = 12 * MiB;
constexpr size_t WS_WOUT = 14 * MiB;
constexpr size_t WS_WFFI = 16 * MiB;
constexpr size_t WS_WFFO = 27 * MiB;
constexpr size_t WS_H1 = 34 * MiB;
constexpr size_t WS_Q = 54 * MiB, WS_V = 64 * MiB, WS_OG = 74 * MiB, WS_POOL = 84 * MiB;
constexpr size_t WS_GA = 94 * MiB, WS_GB = 114 * MiB;
constexpr size_t WS_LOGF = 134 * MiB;
constexpr size_t WS_KK = 174 * MiB;
constexpr size_t WS_OTMP = 194 * MiB;
constexpr size_t WS_SS2 = 194 * MiB;
constexpr size_t WS_ACAT = 214 * MiB;
constexpr size_t WS_MERGED = 234 * MiB;
constexpr size_t WS_X1 = WS_LOGF;
constexpr size_t WS_A2 = WS_H1;
constexpr size_t WS_ACT = WS_Q;
constexpr size_t WS_END = 254 * MiB;

__device__ __forceinline__ float bf2f(bf16_t b) { return __uint_as_float(((unsigned)b) << 16); }
__device__ __forceinline__ bf16_t f2bf(float f) { unsigned u = __float_as_uint(f); u += 0x7fffu + ((u >> 16) & 1u); return (bf16_t)(u >> 16); }
__device__ __forceinline__ float sigmoidf_(float z) { return 1.0f / (1.0f + __expf(-z)); }
__device__ __forceinline__ int grp_of_row(int m) { return m < NCTX ? 0 : 1 + (m - NCTX) / TL; }
__device__ __forceinline__ float wave_sum(float v) {
#pragma unroll
    for (int o = 1; o < 64; o <<= 1) v += __shfl_xor(v, o);
    return v;
}

struct Ptrs {
    const float* x_prompt; const float* x_sample; const float* state; const float* c; const float* c_ctx; const float* w_ada; const float* b_ada;
    const float* norm1_g; const float* w_in; const float* lb_logits; const float* hgrn_norm_g; const float* w_branch_a; const float* pool_w;
    const float* pool_scale; const float* w_branch_b; const float* w_out; const float* norm2_g; const float* w_ffn_in; const float* w_ffn_out; const float* final_g;
    float* out; unsigned char* ws;
};
__device__ __forceinline__ const float* xrow(const Ptrs& P, int m) { return m < NCTX ? P.x_prompt + (size_t)m * D : P.x_sample + (size_t)(m - NCTX) * D; }

__global__ void ks_mod(Ptrs P) {
    const int i = blockIdx.x * blockDim.x + threadIdx.x; if (i >= 3 * MODW) return;
    const int g = i / MODW, n = i % MODW; const float* cv = g == 0 ? P.c_ctx : P.c + (size_t)(g - 1) * D;
    float s = 0.f;
    for (int k = 0; k < D; ++k) { const float c = cv[k]; s += (c * sigmoidf_(c)) * P.w_ada[(size_t)k * MODW + n]; }
    ((float*)(P.ws + WS_MOD))[i] = s + P.b_ada[n];
}
__global__ void ks_convT(const float* src, int K, int N, bf16_t* dst, int ldd, int koff, int mode) {
    const size_t i = (size_t)blockIdx.x * blockDim.x + threadIdx.x; if (i >= (size_t)K * N) return;
    const int k = (int)(i / N), n = (int)(i % N);
    int r = n;
    if (mode == 1) { const int j = n < DFF ? n : n - DFF; r = (j / 128) * 256 + (j % 128) + (n < DFF ? 0 : 128); }
    dst[(size_t)r * ldd + koff + k] = f2bf(src[i]);
}
__global__ void ks_wpb(Ptrs P) {
    const int i = blockIdx.x * blockDim.x + threadIdx.x; if (i >= DB * D) return;
    const int gc = i / D, n = i % D, g = gc / 128;
    float s = 0.f;
    for (int d = 0; d < 128; ++d) s += P.pool_w[(size_t)gc * 128 + d] * P.pool_scale[g * 128 + d] * P.w_branch_b[(size_t)(g * 128 + d) * D + n];
    ((bf16_t*)(P.ws + WS_WCAT))[(size_t)n * 1024 + 512 + gc] = f2bf(s);
}
__global__ void ks_h1(Ptrs P) {
    const int m = (blockIdx.x * blockDim.x + threadIdx.x) >> 6, lane = threadIdx.x & 63; if (m >= M) return;
    const float* xr = xrow(P, m); const float* mod = (const float*)(P.ws + WS_MOD) + (size_t)grp_of_row(m) * MODW;
    float ss = 0.f; for (int k = lane; k < D; k += 64) { const float v = xr[k]; ss += v * v; }
    const float rstd = rsqrtf(wave_sum(ss) * (1.0f / D) + EPS);
    bf16_t* h = (bf16_t*)(P.ws + WS_H1) + (size_t)m * D;
    for (int k = lane; k < D; k += 64) h[k] = f2bf((xr[k] * rstd * P.norm1_g[k]) * (1.0f + mod[D + k]) + mod[k]);
}
__global__ void ks_bias2(Ptrs P) {
    const int i = blockIdx.x * blockDim.x + threadIdx.x; if (i >= 3 * NFF2) return;
    const int g = i / NFF2, n = i % NFF2; const float* sh = (const float*)(P.ws + WS_MOD) + (size_t)g * MODW + 3 * D;
    const bf16_t* w = (const bf16_t*)(P.ws + WS_WFFI) + (size_t)n * D; float s = 0.f;
    for (int k = 0; k < D; ++k) s += sh[k] * bf2f(w[k]);
    ((float*)(P.ws + WS_BIAS2))[i] = s;
}

template <class Epi>
__global__ __launch_bounds__(256) void ks_gemm(const bf16_t* A, int lda, const bf16_t* Bt, int ldb, int K, int Mrows, int Nout, Epi E) {
    const int wave = (blockIdx.x * 256 + threadIdx.x) >> 6, lane = threadIdx.x & 63, row = lane & 15, quad = lane >> 4;
    const int tn_count = Nout / 32, tm = wave / tn_count, tn = wave % tn_count; if (tm >= Mrows / 32) return;
    const int j0 = tn * 32, b1 = Epi::brow1(j0), b2 = Epi::brow2(j0);
    f32x4 acc1[2][2], acc2[2][2];
#pragma unroll
    for (int i = 0; i < 2; ++i)
#pragma unroll
        for (int j = 0; j < 2; ++j) { acc1[i][j] = (f32x4){0.f, 0.f, 0.f, 0.f}; acc2[i][j] = (f32x4){0.f, 0.f, 0.f, 0.f}; }
    for (int k0 = 0; k0 < K; k0 += 32) {
        bf16x8 a[2], b[2];
#pragma unroll
        for (int i = 0; i < 2; ++i) a[i] = *(const bf16x8*)(A + (size_t)(tm * 32 + i * 16 + row) * lda + k0 + quad * 8);
#pragma unroll
        for (int j = 0; j < 2; ++j) b[j] = *(const bf16x8*)(Bt + (size_t)(b1 + j * 16 + row) * ldb + k0 + quad * 8);
#pragma unroll
        for (int i = 0; i < 2; ++i)
#pragma unroll
            for (int j = 0; j < 2; ++j) acc1[i][j] = __builtin_amdgcn_mfma_f32_16x16x32_bf16(a[i], b[j], acc1[i][j], 0, 0, 0);
        if (Epi::DUAL) {
#pragma unroll
            for (int i = 0; i < 2; ++i) a[i] = *(const bf16x8*)(A + (size_t)(tm * 32 + i * 16 + row) * lda + Epi::KOFF2 + k0 + quad * 8);
#pragma unroll
            for (int j = 0; j < 2; ++j) b[j] = *(const bf16x8*)(Bt + (size_t)(b2 + j * 16 + row) * ldb + Epi::KOFF2 + k0 + quad * 8);
#pragma unroll
            for (int i = 0; i < 2; ++i)
#pragma unroll
                for (int j = 0; j < 2; ++j) acc2[i][j] = __builtin_amdgcn_mfma_f32_16x16x32_bf16(a[i], b[j], acc2[i][j], 0, 0, 0);
        }
    }
#pragma unroll
    for (int i = 0; i < 2; ++i)
#pragma unroll
        for (int j = 0; j < 2; ++j)
#pragma unroll
            for (int r = 0; r < 4; ++r) E(tm * 32 + i * 16 + quad * 4 + r, j0 + j * 16 + row, acc1[i][j][r], acc2[i][j][r]);
}

struct EpiG1s {
    static constexpr bool DUAL = false; static constexpr int KOFF2 = 0;
    static __device__ __forceinline__ int brow1(int j0) { return j0; }
    static __device__ __forceinline__ int brow2(int j0) { return j0; }
    unsigned char* ws; const float* lbl;
    __device__ __forceinline__ void operator()(int m, int n, float v, float) const {
        if (n < 512) ((bf16_t*)(ws + WS_Q))[(size_t)m * 512 + n] = f2bf(v);
        else if (n < 1536) {
            const int dd = n - 512;
            const float lb = sigmoidf_(lbl[dd] - lbl[1024 + dd]);
            const float e = __expf(-v), sig = 1.0f / (1.0f + e), f = lb + (1.0f - lb) * sig;
            ((float*)(ws + WS_LOGF))[(size_t)m * 1024 + dd] = __logf(f);
            ((bf16_t*)(ws + WS_KK))[(size_t)m * 1024 + dd] = f2bf((1.0f - lb) * e * sig);
        }
        else if (n < 2048) ((bf16_t*)(ws + WS_V))[(size_t)m * 512 + n - 1536] = f2bf(v);
        else if (n < 2560) ((bf16_t*)(ws + WS_OG))[(size_t)m * 512 + n - 2048] = f2bf(v * sigmoidf_(v));
        else if (n < 3072) ((bf16_t*)(ws + WS_POOL))[(size_t)m * 512 + n - 2560] = f2bf(v);
        else if (n < 4096) ((bf16_t*)(ws + WS_GA))[(size_t)m * 1024 + n - 3072] = f2bf(sigmoidf_(v));
        else ((bf16_t*)(ws + WS_GB))[(size_t)m * 1024 + n - 4096] = f2bf(sigmoidf_(v));
    }
};
struct EpiMerges {
    static constexpr bool DUAL = true; static constexpr int KOFF2 = 512;
    static __device__ __forceinline__ int brow1(int j0) { return j0; }
    static __device__ __forceinline__ int brow2(int j0) { return j0; }
    unsigned char* ws;
    __device__ __forceinline__ void operator()(int m, int n, float v1, float v2) const {
        const float ga = bf2f(((const bf16_t*)(ws + WS_GA))[(size_t)m * 1024 + n]), gb = bf2f(((const bf16_t*)(ws + WS_GB))[(size_t)m * 1024 + n]);
        ((bf16_t*)(ws + WS_MERGED))[(size_t)m * 1024 + n] = f2bf(ga * v1 + gb * v2);
    }
};
struct EpiWouts {
    static constexpr bool DUAL = false; static constexpr int KOFF2 = 0;
    static __device__ __forceinline__ int brow1(int j0) { return j0; }
    static __device__ __forceinline__ int brow2(int j0) { return j0; }
    Ptrs P;
    __device__ __forceinline__ void operator()(int m, int n, float v, float) const {
        const float* mod = (const float*)(P.ws + WS_MOD) + (size_t)grp_of_row(m) * MODW;
        const float x1 = xrow(P, m)[n] + mod[2 * D + n] * v;
        ((float*)(P.ws + WS_X1))[(size_t)m * D + n] = x1;
        ((bf16_t*)(P.ws + WS_A2))[(size_t)m * D + n] = f2bf(x1 * P.norm2_g[n] * (1.0f + mod[4 * D + n]));
    }
};
__global__ void ks_ss2(Ptrs P) {
    const int i = blockIdx.x * blockDim.x + threadIdx.x; if (i >= M * 16) return;
    const float* x1 = (const float*)(P.ws + WS_X1) + (size_t)(i / 16) * D + (i % 16) * 64; float s = 0.f;
    for (int k = 0; k < 64; ++k) s += x1[k] * x1[k];
    ((float*)(P.ws + WS_SS2))[i] = s;
}
struct EpiFfnIns {
    static constexpr bool DUAL = true; static constexpr int KOFF2 = 0;
    static __device__ __forceinline__ int brow1(int j0) { return (j0 / 128) * 256 + (j0 % 128); }
    static __device__ __forceinline__ int brow2(int j0) { return (j0 / 128) * 256 + (j0 % 128) + 128; }
    unsigned char* ws;
    __device__ __forceinline__ void operator()(int m, int j, float v1, float v2) const {
        const float* ss = (const float*)(ws + WS_SS2) + (size_t)m * 16; float s = 0.f;
        for (int p = 0; p < 16; ++p) s += ss[p];
        const float rstd = rsqrtf(s * (1.0f / D) + EPS);
        const float* b2 = (const float*)(ws + WS_BIAS2) + (size_t)grp_of_row(m) * NFF2; const int n1 = (j / 128) * 256 + (j % 128);
        const float gv = v1 * rstd + b2[n1], uv = v2 * rstd + b2[n1 + 128];
        ((bf16_t*)(ws + WS_ACT))[(size_t)m * DFF + j] = f2bf(gv * sigmoidf_(gv) * uv);
    }
};
struct EpiFfnOuts {
    static constexpr bool DUAL = false; static constexpr int KOFF2 = 0;
    static __device__ __forceinline__ int brow1(int j0) { return j0; }
    static __device__ __forceinline__ int brow2(int j0) { return j0; }
    Ptrs P;
    __device__ __forceinline__ void operator()(int m, int n, float v, float) const {
        const float* mod = (const float*)(P.ws + WS_MOD) + (size_t)grp_of_row(m) * MODW;
        P.out[(size_t)m * D + n] = ((const float*)(P.ws + WS_X1))[(size_t)m * D + n] + mod[5 * D + n] * v;
    }
};
__global__ void ks_final(Ptrs P) {
    const int m = (blockIdx.x * blockDim.x + threadIdx.x) >> 6, lane = threadIdx.x & 63; if (m >= M) return;
    float* xr = P.out + (size_t)m * D; float v[16]; float ss = 0.f;
#pragma unroll
    for (int i = 0; i < 16; ++i) { v[i] = xr[lane + 64 * i]; ss += v[i] * v[i]; }
    const float rstd = rsqrtf(wave_sum(ss) * (1.0f / D) + EPS);
#pragma unroll
    for (int i = 0; i < 16; ++i) xr[lane + 64 * i] = v[i] * rstd * P.final_g[lane + 64 * i];
}

__global__ __launch_bounds__(128) void ks_scan(Ptrs P, float* ofwd, float* obwd) {
    __shared__ float fl[128], kl[128], ql[128];
    const int u = blockIdx.x, e = threadIdx.x;
    int b, h, dir, T, row0; const bool ctx = u < BC * NH * 2;
    if (ctx) { b = u / 8; h = (u >> 1) & 3; dir = u & 1; T = TC; row0 = b * TC; }
    else { const int v = u - BC * NH * 2; b = v / 8; h = (v >> 1) & 3; dir = v & 1; T = TL; row0 = NCTX + b * TL; }
    float S[128];
#pragma unroll
    for (int d = 0; d < 128; ++d) S[d] = ctx ? 0.f : P.state[((size_t)((b * 2 + dir) * 4 + h) * 128 + d) * 128 + e];
    const float* LOGF = (const float*)(P.ws + WS_LOGF); const bf16_t* KK = (const bf16_t*)(P.ws + WS_KK);
    const bf16_t* Q = (const bf16_t*)(P.ws + WS_Q); const bf16_t* V = (const bf16_t*)(P.ws + WS_V);
    float* o_out = dir ? obwd : ofwd;
    for (int step = 0; step < T; ++step) {
        const int t = dir ? T - 1 - step : step; const size_t row = (size_t)(row0 + t);
        fl[e] = __expf(LOGF[row * 1024 + dir * 512 + h * 128 + e]); kl[e] = bf2f(KK[row * 1024 + dir * 512 + h * 128 + e]); ql[e] = bf2f(Q[row * 512 + h * 128 + e]);
        const float v = bf2f(V[row * 512 + h * 128 + e]);
        __syncthreads();
        float o = 0.f;
#pragma unroll
        for (int d = 0; d < 128; ++d) { S[d] = fl[d] * S[d] + kl[d] * v; o += ql[d] * S[d]; }
        __syncthreads();
        o_out[row * 512 + h * 128 + e] = o;
    }
    if (ctx) {
        float* ns = P.out + (size_t)M * D + (size_t)((b * 2 + dir) * 4 + h) * 128 * 128;
#pragma unroll
        for (int d = 0; d < 128; ++d) ns[(size_t)d * 128 + e] = S[d];
    }
}
__global__ void ks_ofinal(Ptrs P, const float* ofwd, const float* obwd) {
    const int w = (blockIdx.x * blockDim.x + threadIdx.x) >> 6, lane = threadIdx.x & 63; if (w >= M * NH) return;
    const int m = w / NH, h = w % NH; const size_t base = (size_t)m * 512 + h * 128;
    const float o0 = ofwd[base + lane] + obwd[base + lane], o1 = ofwd[base + 64 + lane] + obwd[base + 64 + lane];
    const float r = rsqrtf(wave_sum(o0 * o0 + o1 * o1) * (1.0f / 128.0f) + EPS);
    const bf16_t* og = (const bf16_t*)(P.ws + WS_OG) + base; bf16_t* dst = (bf16_t*)(P.ws + WS_ACAT) + (size_t)m * 1024 + h * 128;
    dst[lane] = f2bf(o0 * r * P.hgrn_norm_g[h * 128 + lane] * bf2f(og[lane]));
    dst[64 + lane] = f2bf(o1 * r * P.hgrn_norm_g[h * 128 + 64 + lane] * bf2f(og[64 + lane]));
}
__global__ void ks_pool(Ptrs P) {
    const int i = blockIdx.x * blockDim.x + threadIdx.x; if (i >= M * DB) return;
    const int m = i / DB, c = i % DB, w = 2 << (c / 128); const bf16_t* Z = (const bf16_t*)(P.ws + WS_POOL);
    float s = 0.f; int cnt;
    if (m < NCTX) {
        const int b = m / TC, pos = m % TC; int lo = pos - w / 2, hi = pos + w / 2 - 1; lo = lo < 0 ? 0 : lo; hi = hi > TC - 1 ? TC - 1 : hi;
        for (int t = lo; t <= hi; ++t) s += bf2f(Z[(size_t)(b * TC + t) * DB + c]);
        cnt = hi - lo + 1;
    } else {
        const int ml = m - NCTX, b = ml / TL, t = ml % TL, r = t / GRID_W, cc = t % GRID_W;
        int rlo = r - w / 2, rhi = r + w / 2 - 1, clo = cc - w / 2, chi = cc + w / 2 - 1;
        rlo = rlo < 0 ? 0 : rlo; rhi = rhi > GRID_H - 1 ? GRID_H - 1 : rhi; clo = clo < 0 ? 0 : clo; chi = chi > GRID_W - 1 ? GRID_W - 1 : chi;
        for (int rr = rlo; rr <= rhi; ++rr) for (int c2 = clo; c2 <= chi; ++c2) s += bf2f(Z[(size_t)(NCTX + b * TL + rr * GRID_W + c2) * DB + c]);
        cnt = (rhi - rlo + 1) * (chi - clo + 1);
    }
    ((bf16_t*)(P.ws + WS_ACAT))[(size_t)m * 1024 + 512 + c] = f2bf(s / (float)cnt - bf2f(Z[(size_t)m * DB + c]));
}


namespace pg8 {
#define PG8_LAS __attribute__((address_space(3)))
typedef unsigned short bf16_t;
typedef short bf16x8 __attribute__((ext_vector_type(8)));
typedef float f32x4 __attribute__((ext_vector_type(4)));
typedef unsigned u32x4 __attribute__((ext_vector_type(4)));
constexpr int BM = 256, BK = 64, HALF = 128, HTB = HALF * BK * 2  , STAGE_BYTES = 8 * HTB, NXCD = 8, WGM = 8;

__host__ __device__ __forceinline__ int lds_byte(int r, int c) { const int st = (r >> 4) * 2 + (c >> 5), rr = r & 15, cc = c & 31, ob = rr * 64 + cc * 2; return st * 1024 + (ob ^ (((ob >> 9) & 1) << 5)); }
__host__ __device__ __forceinline__ void stage_rc(int b, int& R, int& C) { const int st = b / 1024, sb = b % 1024, swz = sb ^ (((sb >> 9) & 1) << 5); R = (st >> 1) * 16 + swz / 64; C = (st & 1) * 32 + (swz % 64) / 2; }
__host__ __device__ __forceinline__ int perm32(int rho) { const int n = rho >> 4, i = rho & 15; return 8 * (i >> 2) + 4 * n + (i & 3); }

struct Unit { int pm, pn; };
struct Gemm { const bf16_t* A; const bf16_t* Bt; int M, N, K; };

struct StaticOrder {
    int nM, nN, nwg, G, c;
    __host__ __device__ void init(int M, int N, int G_, int c_) { nM = M / BM; nN = N / BM; nwg = nM * nN; G = G_; c = c_; }
    __host__ __device__ bool next(int i, Unit& u) const {
        const long L = (long)i * G + c; if (L >= nwg) return false;
        int wgid = (int)L; { const int q = nwg / NXCD, r = nwg % NXCD, xcd = wgid % NXCD, off = wgid / NXCD; wgid = (xcd < r ? xcd * (q + 1) : r * (q + 1) + (xcd - r) * q) + off; }
        const int nig = WGM * nN, gid = wgid / nig, fm = gid * WGM, gsz = (nM - fm) < WGM ? (nM - fm) : WGM;
        u.pm = fm + ((wgid % nig) % gsz); u.pn = (wgid % nig) / gsz; return true;
    }
    __device__ __forceinline__ void a_ready(const Unit&) const {}
    __device__ __forceinline__ void done(const Unit&) const {}
};
template <class Epi, class Sched, bool ALIGN_EPI = false, bool SP2 = false>
__device__ __forceinline__ void gemm_phase(PG8_LAS unsigned char* lds, const Gemm g, const Sched& S, const Epi& E) {
    const int tid = threadIdx.x, wid = __builtin_amdgcn_readfirstlane(tid >> 6), lane = tid & 63, wr = wid >> 2, wc = wid & 3, fr = lane & 15, fq = lane >> 4;
    const int K = g.K, nt = K / BK;
    unsigned voffA[2], voffB[2];
#pragma unroll
    for (int i = 0; i < 2; ++i) { int R, C; stage_rc(tid * 16 + i * 8192, R, C); const int Rb = Epi::PERM ? ((R & ~31) + perm32(R & 31)) : R;
        voffA[i] = (unsigned)(R * K + C) * 2u; voffB[i] = (unsigned)(Rb * K + C) * 2u; }
    const size_t kstep = (size_t)(BK * 2);
    const size_t hstep = (size_t)HALF * K * 2;
    const size_t tstep = 2 * hstep;
    const unsigned ldsw = (unsigned)wid * 1024u;
    const int aoff = lds_byte(wr * 64 + fr, fq * 8), boff = lds_byte(wc * 32 + fr, fq * 8);
#define PG8_SA(b, h) (((b) * 2 + (h)) * HTB)
#define PG8_SB(b, h) ((4 + (b) * 2 + (h)) * HTB)
#define PG8_STAGE(bufoff, gbase, voff) do { _Pragma("unroll") for (int _i = 0; _i < 2; ++_i) \
        __builtin_amdgcn_global_load_lds((const unsigned*)((const char*)(gbase) + (voff)[_i]), (PG8_LAS unsigned*)(lds + (bufoff) + ldsw + _i * 8192), 16, 0, 0); } while (0)
#define PG8_LDA(dst, b, h) do { _Pragma("unroll") for (int m = 0; m < 4; ++m) _Pragma("unroll") for (int k = 0; k < 2; ++k) dst[m][k] = *(const PG8_LAS bf16x8*)(lds + PG8_SA(b, h) + aoff + m * 2048 + k * 1024); } while (0)
#define PG8_LDB(dst, b, h) do { _Pragma("unroll") for (int n = 0; n < 2; ++n) _Pragma("unroll") for (int k = 0; k < 2; ++k) dst[n][k] = *(const PG8_LAS bf16x8*)(lds + PG8_SB(b, h) + boff + n * 2048 + k * 1024); } while (0)
#define PG8_MMA(ai, bj, At, Bt) do { __builtin_amdgcn_s_setprio(1); _Pragma("unroll") for (int m = 0; m < 4; ++m) _Pragma("unroll") for (int n = 0; n < 2; ++n) _Pragma("unroll") for (int k = 0; k < 2; ++k) \
        acc[ai][bj][m][n] = __builtin_amdgcn_mfma_f32_16x16x32_bf16(Bt[n][k], At[m][k], acc[ai][bj][m][n], 0, 0, 0); __builtin_amdgcn_s_setprio(0); } while (0)
#define PG8_WAIT_V(n) asm volatile("s_waitcnt vmcnt(" #n ")" ::: "memory")
#define PG8_WAIT_L(n) asm volatile("s_waitcnt lgkmcnt(" #n ")" ::: "memory")
#define PG8_BAR __builtin_amdgcn_s_barrier()
#define PG8_SCHED __builtin_amdgcn_sched_barrier(0)
    Unit cur, nxt; int ui = 0;
    if (!S.next(0, cur)) return;
    f32x4 acc[2][2][4][2];
#pragma unroll
    for (int a = 0; a < 2; ++a)
#pragma unroll
        for (int b = 0; b < 2; ++b)
#pragma unroll
            for (int m = 0; m < 4; ++m)
#pragma unroll
                for (int n = 0; n < 2; ++n) acc[a][b][m][n] = (f32x4){0.f, 0.f, 0.f, 0.f};
    bf16x8 At[4][2], B0[2][2], B1[2][2];
    const char* cA = (const char*)g.A + (size_t)cur.pm * tstep; const char* cB = (const char*)g.Bt + (size_t)cur.pn * tstep;
    S.a_ready(cur);
    if constexpr (SP2) {
        PG8_STAGE(PG8_SB(0, 0), cB, voffB); PG8_STAGE(PG8_SB(0, 1), cB + hstep, voffB); PG8_STAGE(PG8_SA(0, 0), cA, voffA); PG8_STAGE(PG8_SA(0, 1), cA + hstep, voffA);
        if (wr == 1) PG8_BAR;
        PG8_WAIT_V(2); PG8_BAR;
        PG8_STAGE(PG8_SB(1, 0), cB + kstep, voffB); PG8_STAGE(PG8_SA(1, 0), cA + kstep, voffA); PG8_STAGE(PG8_SB(1, 1), cB + hstep + kstep, voffB);
        PG8_WAIT_V(6); PG8_BAR;
    } else {
        PG8_STAGE(PG8_SB(0, 0), cB, voffB); PG8_STAGE(PG8_SA(0, 0), cA, voffA); PG8_STAGE(PG8_SB(0, 1), cB + hstep, voffB); PG8_STAGE(PG8_SA(0, 1), cA + hstep, voffA);
        if (wr == 1) PG8_BAR;
        PG8_WAIT_V(4); PG8_BAR;
        PG8_STAGE(PG8_SB(1, 0), cB + kstep, voffB); PG8_STAGE(PG8_SA(1, 0), cA + kstep, voffA); PG8_STAGE(PG8_SB(1, 1), cB + hstep + kstep, voffB);
        PG8_WAIT_V(6); PG8_BAR;
    }
    for (;;) {
        const bool has_next = S.next(ui + 1, nxt);
        const char* nA = has_next ? (const char*)g.A + (size_t)nxt.pm * tstep : cA; const char* nB = has_next ? (const char*)g.Bt + (size_t)nxt.pn * tstep : cB;
        for (int t = 0; t < nt; t += 2) {
            const bool last = (t == nt - 2);
            const char* a1 = cA + (size_t)(t + 1) * kstep;
            const char* a2 = last ? nA : cA + (size_t)(t + 2) * kstep; const char* b2 = last ? nB : cB + (size_t)(t + 2) * kstep;
            const char* a3 = a2 + kstep; const char* b3 = b2 + kstep;
            if constexpr (Epi::MID) { if (t == (nt >> 1)) E.mid(acc, cur, wr, wc, fr, fq); }
            if (last && has_next) S.a_ready(nxt);
            if constexpr (SP2) {
            PG8_LDB(B0, 0, 0); PG8_LDB(B1, 0, 1); PG8_SCHED; PG8_LDA(At, 0, 0); PG8_STAGE(PG8_SA(1, 1), a1 + hstep, voffA);
            PG8_WAIT_V(8); PG8_WAIT_L(0); PG8_BAR; PG8_MMA(0, 0, At, B0); PG8_MMA(0, 1, At, B1); PG8_BAR; PG8_SCHED;
            PG8_LDA(At, 0, 1); PG8_STAGE(PG8_SB(0, 0), b2, voffB); PG8_STAGE(PG8_SB(0, 1), b2 + hstep, voffB); PG8_STAGE(PG8_SA(0, 0), a2, voffA);
            PG8_WAIT_V(8); PG8_WAIT_L(0); PG8_BAR; PG8_MMA(1, 0, At, B0); PG8_MMA(1, 1, At, B1); PG8_BAR; PG8_SCHED;
            PG8_LDB(B0, 1, 0); PG8_LDB(B1, 1, 1); PG8_SCHED; PG8_LDA(At, 1, 0); PG8_STAGE(PG8_SA(0, 1), a2 + hstep, voffA);
            PG8_WAIT_V(8); PG8_WAIT_L(0); PG8_BAR; PG8_MMA(0, 0, At, B0); PG8_MMA(0, 1, At, B1); PG8_BAR; PG8_SCHED;
            PG8_LDA(At, 1, 1); PG8_STAGE(PG8_SB(1, 0), b3, voffB); PG8_STAGE(PG8_SB(1, 1), b3 + hstep, voffB); PG8_STAGE(PG8_SA(1, 0), a3, voffA);
            PG8_WAIT_V(8); PG8_WAIT_L(0); PG8_BAR; PG8_MMA(1, 0, At, B0); PG8_MMA(1, 1, At, B1); PG8_BAR; PG8_SCHED;
            } else {
            PG8_LDB(B0, 0, 0); PG8_SCHED; PG8_LDA(At, 0, 0); PG8_STAGE(PG8_SA(1, 1), a1 + hstep, voffA);
            PG8_WAIT_L(8); PG8_BAR; PG8_WAIT_L(0); PG8_MMA(0, 0, At, B0); PG8_BAR; PG8_SCHED;
            PG8_LDB(B1, 0, 1); PG8_STAGE(PG8_SB(0, 0), b2, voffB);
            PG8_BAR; PG8_WAIT_L(0); PG8_MMA(0, 1, At, B1); PG8_BAR;
            PG8_LDA(At, 0, 1); PG8_STAGE(PG8_SA(0, 0), a2, voffA);
            PG8_BAR; PG8_WAIT_L(0); PG8_MMA(1, 0, At, B0); PG8_BAR; PG8_SCHED;
            PG8_STAGE(PG8_SB(0, 1), b2 + hstep, voffB);
            PG8_WAIT_V(6); PG8_BAR; PG8_MMA(1, 1, At, B1); PG8_BAR;
            PG8_LDB(B0, 1, 0); PG8_SCHED; PG8_LDA(At, 1, 0); PG8_STAGE(PG8_SA(0, 1), a2 + hstep, voffA);
            PG8_WAIT_L(8); PG8_BAR; PG8_WAIT_L(0); PG8_MMA(0, 0, At, B0); PG8_BAR; PG8_SCHED;
            PG8_LDB(B1, 1, 1); PG8_STAGE(PG8_SB(1, 0), b3, voffB);
            PG8_BAR; PG8_WAIT_L(0); PG8_MMA(0, 1, At, B1); PG8_BAR;
            PG8_LDA(At, 1, 1); PG8_STAGE(PG8_SA(1, 0), a3, voffA);
            PG8_BAR; PG8_WAIT_L(0); PG8_MMA(1, 0, At, B0); PG8_BAR; PG8_SCHED;
            PG8_STAGE(PG8_SB(1, 1), b3 + hstep, voffB);
            PG8_WAIT_V(6); PG8_BAR; PG8_MMA(1, 1, At, B1); PG8_BAR;
            }
        }
        if constexpr (ALIGN_EPI) { if (wr == 0) PG8_BAR; }
        if constexpr (!Epi::AFTER_DRAIN) { E(acc, cur, wr, wc, fr, fq); S.done(cur); }
        if (!has_next) break;
#pragma unroll
        for (int a = 0; a < 2; ++a)
#pragma unroll
            for (int b = 0; b < 2; ++b)
#pragma unroll
                for (int m = 0; m < 4; ++m)
#pragma unroll
                    for (int n = 0; n < 2; ++n) acc[a][b][m][n] = (f32x4){0.f, 0.f, 0.f, 0.f};
        cur = nxt; cA = nA; cB = nB; ++ui;
        if constexpr (ALIGN_EPI) { if (wr == 1) PG8_BAR; }
    }
    PG8_WAIT_V(0);
    if constexpr (!ALIGN_EPI) { if (wr == 0) PG8_BAR; }
    PG8_BAR;
    if constexpr (Epi::AFTER_DRAIN) { E.fused(acc, cur, wr, wc, fr, fq, lds, wid, lane); S.done(cur); }
#undef PG8_SA
#undef PG8_SB
#undef PG8_STAGE
#undef PG8_LDA
#undef PG8_LDB
#undef PG8_MMA
#undef PG8_WAIT_V
#undef PG8_WAIT_L
#undef PG8_BAR
#undef PG8_SCHED
}
}

#define LAS __attribute__((address_space(3)))
#define RLX_AGENT __ATOMIC_RELAXED, __HIP_MEMORY_SCOPE_AGENT
#define XB_TMO      128
#define XB_XCNT(j)  (256  + 64 * (j))
#define XB_XSUB(j)  (1280 + 64 * (j))
#define XB_XGEN(j)  (2304 + 64 * (j))
#define XB_TOP      3328
#define XB_TOPGEN   3392
#define XCD_BAR_WORDS 3456
#define XB_SPIN_CAP (1u << 18)

__device__ __forceinline__ unsigned xb_ld(unsigned* p)              { return __hip_atomic_load(p, __ATOMIC_RELAXED, __HIP_MEMORY_SCOPE_AGENT); }
__device__ __forceinline__ unsigned xb_add(unsigned* p, unsigned v) { return __hip_atomic_fetch_add(p, v, __ATOMIC_RELAXED, __HIP_MEMORY_SCOPE_AGENT); }
__device__ __forceinline__ unsigned xb_xcc_id() { return (unsigned)__builtin_amdgcn_s_getreg((3 << 11) | 20) & 0xFu; }
#define XB_SPIN(cond, bar) do { unsigned _sp = 0; while (cond) { __builtin_amdgcn_s_sleep(1); \
    if ((++_sp & 255u) == 0u) { if (xb_ld(&(bar)[XB_TMO])) break; if (_sp > XB_SPIN_CAP) { atomicAdd(&(bar)[XB_TMO], 1u); break; } } } } while (0)

struct XcdBarrier {
    unsigned* bar; unsigned x;
    volatile LAS unsigned* st;
};

__device__ __forceinline__ XcdBarrier xcd_barrier_post(unsigned* bar, volatile LAS unsigned* st) {
    XcdBarrier b; b.bar = bar; b.x = xb_xcc_id(); b.st = st;
    if (threadIdx.x == 0) (void)xb_add(&bar[XB_XCNT(b.x)], 1u);
    return b;
}
__device__ __forceinline__ void xcd_barrier_complete(unsigned* bar, unsigned x, unsigned& nloc, unsigned& nx) {
    const unsigned G = gridDim.x * gridDim.y * gridDim.z;
    unsigned sum, cnt, mine, sp = 0u;
    for (;;) {
        sum = 0u; cnt = 0u; mine = 0u;
#pragma unroll
        for (unsigned j = 0; j < 16; ++j) { const unsigned c = xb_ld(&bar[XB_XCNT(j)]); sum += c; cnt += (c > 0u) ? 1u : 0u; mine = (j == x) ? c : mine; }
        if (sum == G) break;
        __builtin_amdgcn_s_sleep(1);
        if ((++sp & 255u) == 0u) { if (xb_ld(&bar[XB_TMO])) break; if (sp > XB_SPIN_CAP) { atomicAdd(&bar[XB_TMO], 1u); break; } }
    }
    nloc = mine > 0u ? mine : 1u; nx = cnt > 0u ? cnt : 1u;
}

__device__ __forceinline__ void xcd_barrier(const XcdBarrier& b) {
    asm volatile("s_waitcnt vmcnt(0)" ::: "memory");
    __syncthreads();
    if (threadIdx.x == 0) {
        unsigned* bar = b.bar;
        __builtin_amdgcn_s_waitcnt(0);
        unsigned nloc = b.st[0], nx = b.st[1];
        if (nloc == 0u) { xcd_barrier_complete(bar, b.x, nloc, nx); b.st[0] = nloc; b.st[1] = nx; }
        const unsigned old = xb_add(&bar[XB_XSUB(b.x)], 1u);
        const unsigned gen = old / nloc;
        if (old + 1u == (gen + 1u) * nloc) {
            __builtin_amdgcn_fence(__ATOMIC_RELEASE, "agent");
            asm volatile("s_waitcnt vmcnt(0)" ::: "memory");
            const unsigned og = xb_add(&bar[XB_TOP], 1u);
            const unsigned tg = og / nx;
            if (og + 1u == (tg + 1u) * nx) xb_add(&bar[XB_TOPGEN], 1u);
            else XB_SPIN(xb_ld(&bar[XB_TOPGEN]) == tg, bar);
            __builtin_amdgcn_fence(__ATOMIC_ACQUIRE, "agent");
            xb_add(&bar[XB_XGEN(b.x)], 1u);
            asm volatile("s_waitcnt vmcnt(0)" ::: "memory");
        } else {
            XB_SPIN(xb_ld(&bar[XB_XGEN(b.x)]) == gen, bar);
            __builtin_amdgcn_fence(__ATOMIC_ACQUIRE, "agent");
            asm volatile("s_waitcnt vmcnt(0)" ::: "memory");
        }
    }
    __syncthreads();
}

typedef unsigned u32x4 __attribute__((ext_vector_type(4)));
typedef float f32x2_t __attribute__((ext_vector_type(2)));
typedef __bf16 bf16x2_t __attribute__((ext_vector_type(2)));
__device__ __forceinline__ unsigned cvtpk(float lo, float hi) { f32x2_t v = {lo, hi}; bf16x2_t b = __builtin_convertvector(v, bf16x2_t); return __builtin_bit_cast(unsigned, b); }
__device__ __forceinline__ u32x4 pack8(const float* v) { u32x4 w; w.x = cvtpk(v[0], v[1]); w.y = cvtpk(v[2], v[3]); w.z = cvtpk(v[4], v[5]); w.w = cvtpk(v[6], v[7]); return w; }
__device__ __forceinline__ void unpack8(const u32x4 w, float* f) {
    f[0] = __uint_as_float(w.x << 16); f[1] = __uint_as_float(w.x & 0xffff0000u); f[2] = __uint_as_float(w.y << 16); f[3] = __uint_as_float(w.y & 0xffff0000u);
    f[4] = __uint_as_float(w.z << 16); f[5] = __uint_as_float(w.z & 0xffff0000u); f[6] = __uint_as_float(w.w << 16); f[7] = __uint_as_float(w.w & 0xffff0000u);
}
__device__ __forceinline__ float fsig(float z) { return __builtin_amdgcn_rcpf(1.0f + __expf(-z)); }
__device__ __forceinline__ int grp_of_pm(int pm) { return pm < NCTX / 256 ? 0 : 1 + (pm - NCTX / 256) / (TL / 256); }
#define ACC8(v, a) do { v[0] = a[0][0]; v[1] = a[0][1]; v[2] = a[0][2]; v[3] = a[0][3]; v[4] = a[1][0]; v[5] = a[1][1]; v[6] = a[1][2]; v[7] = a[1][3]; } while (0)

struct EpiG1 {
    static constexpr bool PERM = true, AFTER_DRAIN = false, MID = false;
    unsigned char* ws; const float* lbl;
    __device__ __forceinline__ void operator()(const f32x4 (&acc)[2][2][4][2], const pg8::Unit& u, int wr, int wc, int fr, int fq) const {
        const int row0 = u.pm * 256 + wr * 64 + fr, cl = wc * 32 + 8 * fq, pn = u.pn;
        if (pn >= 2 && pn < 6) {
#pragma unroll
            for (int bj = 0; bj < 2; ++bj) {
                const int dd = (pn - 2) * 256 + bj * 128 + cl;
                float oml[8], lb[8];
#pragma unroll
                for (int e = 0; e < 8; ++e) { lb[e] = fsig(lbl[dd + e] - lbl[1024 + dd + e]); oml[e] = 1.0f - lb[e]; }
#pragma unroll
                for (int ai = 0; ai < 2; ++ai)
#pragma unroll
                    for (int m = 0; m < 4; ++m) {
                        const size_t row = (size_t)(row0 + ai * 128 + m * 16);
                        float v[8], lf[8], kk[8]; ACC8(v, acc[ai][bj][m]);
#pragma unroll
                        for (int e = 0; e < 8; ++e) { const float ex = __expf(fminf(-v[e], 80.0f)), sig = __builtin_amdgcn_rcpf(1.0f + ex); lf[e] = __logf(lb[e] + oml[e] * sig); kk[e] = oml[e] * ex * sig; }
                        float* lp = (float*)(ws + WS_LOGF) + row * 1024 + dd;
                        *(f32x4*)lp = (f32x4){lf[0], lf[1], lf[2], lf[3]}; *(f32x4*)(lp + 4) = (f32x4){lf[4], lf[5], lf[6], lf[7]};
                        *(u32x4*)((bf16_t*)(ws + WS_KK) + row * 1024 + dd) = pack8(kk);
                    }
            }
        } else {
            bf16_t* dst; int ldc, c0, act;
            if (pn < 2) { dst = (bf16_t*)(ws + WS_Q); ldc = 512; c0 = pn * 256; act = 0; }
            else if (pn < 8) { dst = (bf16_t*)(ws + WS_V); ldc = 512; c0 = (pn - 6) * 256; act = 0; }
            else if (pn < 10) { dst = (bf16_t*)(ws + WS_OG); ldc = 512; c0 = (pn - 8) * 256; act = 1; }
            else if (pn < 12) { dst = (bf16_t*)(ws + WS_POOL); ldc = 512; c0 = (pn - 10) * 256; act = 0; }
            else if (pn < 16) { dst = (bf16_t*)(ws + WS_GA); ldc = 1024; c0 = (pn - 12) * 256; act = 2; }
            else { dst = (bf16_t*)(ws + WS_GB); ldc = 1024; c0 = (pn - 16) * 256; act = 2; }
#pragma unroll
            for (int ai = 0; ai < 2; ++ai)
#pragma unroll
                for (int m = 0; m < 4; ++m) {
                    bf16_t* rowp = dst + (size_t)(row0 + ai * 128 + m * 16) * ldc + c0 + cl;
#pragma unroll
                    for (int bj = 0; bj < 2; ++bj) {
                        float v[8]; ACC8(v, acc[ai][bj][m]);
                        if (act != 0) {
#pragma unroll
                            for (int e = 0; e < 8; ++e) { const float s = fsig(v[e]); v[e] = act == 1 ? v[e] * s : s; }
                        }
                        *(u32x4*)(rowp + bj * 128) = pack8(v);
                    }
                }
        }
    }
};

struct EpiMerge {
    static constexpr bool PERM = true, AFTER_DRAIN = false, MID = true;
    unsigned char* ws;
    __device__ __forceinline__ void mid(f32x4 (&acc)[2][2][4][2], const pg8::Unit& u, int wr, int wc, int fr, int fq) const {
        int row0 = u.pm * 256 + wr * 64 + fr; const int col0 = u.pn * 256 + wc * 32 + 8 * fq;
        asm volatile("" : "+v"(row0));
#pragma unroll
        for (int ai = 0; ai < 2; ++ai)
#pragma unroll
            for (int m = 0; m < 4; ++m)
#pragma unroll
                for (int bj = 0; bj < 2; ++bj) {
                    const size_t off = (size_t)(row0 + ai * 128 + m * 16) * 1024 + col0 + bj * 128;
                    float ga[8], gb[8]; unpack8(*(const u32x4*)((const bf16_t*)(ws + WS_GA) + off), ga); unpack8(*(const u32x4*)((const bf16_t*)(ws + WS_GB) + off), gb);
#pragma unroll
                    for (int e = 0; e < 8; ++e) acc[ai][bj][m][e >> 2][e & 3] *= ga[e] * __builtin_amdgcn_rcpf(gb[e]);
                    asm volatile("" ::: "memory");
                }
    }
    __device__ __forceinline__ void operator()(const f32x4 (&acc)[2][2][4][2], const pg8::Unit& u, int wr, int wc, int fr, int fq) const {
        const int row0 = u.pm * 256 + wr * 64 + fr, col0 = u.pn * 256 + wc * 32 + 8 * fq;
#pragma unroll
        for (int ai = 0; ai < 2; ++ai)
#pragma unroll
            for (int m = 0; m < 4; ++m)
#pragma unroll
                for (int bj = 0; bj < 2; ++bj) {
                    const size_t off = (size_t)(row0 + ai * 128 + m * 16) * 1024 + col0 + bj * 128;
                    float gb[8], v[8]; unpack8(*(const u32x4*)((const bf16_t*)(ws + WS_GB) + off), gb); ACC8(v, acc[ai][bj][m]);
#pragma unroll
                    for (int e = 0; e < 8; ++e) v[e] *= gb[e];
                    *(u32x4*)((bf16_t*)(ws + WS_MERGED) + off) = pack8(v);
                }
    }
};

struct EpiWout {
    static constexpr bool PERM = true, AFTER_DRAIN = false, MID = false;
    Ptrs P;
    __device__ __forceinline__ void operator()(const f32x4 (&acc)[2][2][4][2], const pg8::Unit& u, int wr, int wc, int fr, int fq) const {
        const int row0 = u.pm * 256 + wr * 64 + fr, col0 = u.pn * 256 + wc * 32 + 8 * fq;
        const float* mod = (const float*)(P.ws + WS_MOD) + (size_t)grp_of_pm(u.pm) * MODW;
        float ss[2][4];
#pragma unroll
        for (int ai = 0; ai < 2; ++ai)
#pragma unroll
            for (int m = 0; m < 4; ++m) ss[ai][m] = 0.f;
#pragma unroll
        for (int bj = 0; bj < 2; ++bj) {
            const int col = col0 + bj * 128; float g1[8], g2s[8];
#pragma unroll
            for (int e = 0; e < 8; ++e) { g1[e] = mod[2 * D + col + e]; g2s[e] = P.norm2_g[col + e] * (1.0f + mod[4 * D + col + e]); }
#pragma unroll
            for (int ai = 0; ai < 2; ++ai)
#pragma unroll
                for (int m = 0; m < 4; ++m) {
                    const int row = row0 + ai * 128 + m * 16; const float* xr = xrow(P, row) + col;
                    const f32x4 xa = *(const f32x4*)xr, xb = *(const f32x4*)(xr + 4);
                    float v[8], a2[8]; ACC8(v, acc[ai][bj][m]);
                    const float xv[8] = {xa[0], xa[1], xa[2], xa[3], xb[0], xb[1], xb[2], xb[3]};
                    float s = 0.f;
#pragma unroll
                    for (int e = 0; e < 8; ++e) { v[e] = xv[e] + g1[e] * v[e]; s += v[e] * v[e]; a2[e] = v[e] * g2s[e]; }
                    ss[ai][m] += s;
                    float* x1p = (float*)(P.ws + WS_X1) + (size_t)row * D + col;
                    *(f32x4*)x1p = (f32x4){v[0], v[1], v[2], v[3]}; *(f32x4*)(x1p + 4) = (f32x4){v[4], v[5], v[6], v[7]};
                    *(u32x4*)((bf16_t*)(P.ws + WS_A2) + (size_t)row * D + col) = pack8(a2);
                }
        }
#pragma unroll
        for (int ai = 0; ai < 2; ++ai)
#pragma unroll
            for (int m = 0; m < 4; ++m) {
                float s = ss[ai][m]; s += __shfl_xor(s, 16); s += __shfl_xor(s, 32);
                if (fq == 0) ((float*)(P.ws + WS_SS2))[(size_t)(row0 + ai * 128 + m * 16) * 16 + u.pn * 4 + wc] = s;
            }
    }
};

struct EpiFfnIn {
    static constexpr bool PERM = true, AFTER_DRAIN = false, MID = false;
    unsigned char* ws;
    __device__ __forceinline__ void operator()(const f32x4 (&acc)[2][2][4][2], const pg8::Unit& u, int wr, int wc, int fr, int fq) const {
        const int row0 = u.pm * 256 + wr * 64 + fr, cl = wc * 32 + 8 * fq;
        const float* b2 = (const float*)(ws + WS_BIAS2) + (size_t)grp_of_pm(u.pm) * NFF2 + u.pn * 256 + cl;
        float bg[8], bu[8];
#pragma unroll
        for (int e = 0; e < 8; ++e) { bg[e] = b2[e]; bu[e] = b2[128 + e]; }
#pragma unroll
        for (int ai = 0; ai < 2; ++ai)
#pragma unroll
            for (int m = 0; m < 4; ++m) {
                const int row = row0 + ai * 128 + m * 16; const f32x4* sp = (const f32x4*)((const float*)(ws + WS_SS2) + (size_t)row * 16);
                const f32x4 s0 = sp[0], s1 = sp[1], s2 = sp[2], s3 = sp[3];
                float s = 0.f;
#pragma unroll
                for (int e = 0; e < 4; ++e) s += s0[e];
#pragma unroll
                for (int e = 0; e < 4; ++e) s += s1[e];
#pragma unroll
                for (int e = 0; e < 4; ++e) s += s2[e];
#pragma unroll
                for (int e = 0; e < 4; ++e) s += s3[e];
                const float rstd = rsqrtf(s * (1.0f / D) + EPS);
                float g[8], uu[8]; ACC8(g, acc[ai][0][m]); ACC8(uu, acc[ai][1][m]);
#pragma unroll
                for (int e = 0; e < 8; ++e) { const float gv = g[e] * rstd + bg[e], uv = uu[e] * rstd + bu[e]; g[e] = gv * fsig(gv) * uv; }
                *(u32x4*)((bf16_t*)(ws + WS_ACT) + (size_t)row * DFF + u.pn * 128 + cl) = pack8(g);
            }
    }
};

struct EpiFfnOut {
    static constexpr bool PERM = true, AFTER_DRAIN = false, MID = false;
    Ptrs P;
    __device__ __forceinline__ void operator()(const f32x4 (&acc)[2][2][4][2], const pg8::Unit& u, int wr, int wc, int fr, int fq) const {
        const int row0 = u.pm * 256 + wr * 64 + fr, col0 = u.pn * 256 + wc * 32 + 8 * fq;
        const float* mod = (const float*)(P.ws + WS_MOD) + (size_t)grp_of_pm(u.pm) * MODW + 5 * D;
#pragma unroll
        for (int bj = 0; bj < 2; ++bj) {
            const int col = col0 + bj * 128; float g2[8];
#pragma unroll
            for (int e = 0; e < 8; ++e) g2[e] = mod[col + e];
#pragma unroll
            for (int ai = 0; ai < 2; ++ai)
#pragma unroll
                for (int m = 0; m < 4; ++m) {
                    const size_t off = (size_t)(row0 + ai * 128 + m * 16) * D + col; const float* x1p = (const float*)(P.ws + WS_X1) + off;
                    const f32x4 xa = *(const f32x4*)x1p, xb = *(const f32x4*)(x1p + 4);
                    float v[8]; ACC8(v, acc[ai][bj][m]);
                    *(f32x4*)(P.out + off) = (f32x4){xa[0] + g2[0] * v[0], xa[1] + g2[1] * v[1], xa[2] + g2[2] * v[2], xa[3] + g2[3] * v[3]};
                    *(f32x4*)(P.out + off + 4) = (f32x4){xb[0] + g2[4] * v[4], xb[1] + g2[5] * v[5], xb[2] + g2[6] * v[6], xb[3] + g2[7] * v[7]};
                }
        }
    }
};


constexpr int NWAVES = 8;
constexpr int RING_BYTES = 131072, LDSCTL_OFF = RING_BYTES, MISC_OFF = LDSCTL_OFF + 320, LDS_BYTES = 147456;
constexpr int CW_BAR = 4096;
constexpr size_t CTL_ZERO_BYTES = 64 * 1024;
static_assert((CW_BAR + XCD_BAR_WORDS) * 4 <= (int)CTL_ZERO_BYTES, "barrier words inside the memset region");
constexpr int N_PHASES = 9;


typedef short s16x4 __attribute__((ext_vector_type(4)));
typedef short v4i16_t __attribute__((ext_vector_type(4)));
typedef float f32x16 __attribute__((ext_vector_type(16)));
#define LDS_WAIT() asm volatile("s_waitcnt lgkmcnt(0)" ::: "memory")
#define VM_WAIT() asm volatile("s_waitcnt vmcnt(0)" ::: "memory")
constexpr size_t WS_MODP = WS_ACAT;

__device__ __forceinline__ void transpose_item(const float* W, int N, bf16_t* WT, int ldd, int drow0, int k0, int n0, LAS float* scr, int lane) {
#pragma unroll 8
    for (int i = 0; i < 32; ++i) { const int kk = 2 * i + (lane >> 5); scr[kk * 33 + (lane & 31)] = W[(size_t)(k0 + kk) * N + n0 + (lane & 31)]; }
    LDS_WAIT();
    const int c = lane & 7;
#pragma unroll
    for (int j = 0; j < 4; ++j) { const int n = (lane >> 3) + 8 * j; const LAS float* s = scr + (8 * c) * 33 + n;
        u32x4 o; o.x = cvtpk(s[0 * 33], s[1 * 33]); o.y = cvtpk(s[2 * 33], s[3 * 33]); o.z = cvtpk(s[4 * 33], s[5 * 33]); o.w = cvtpk(s[6 * 33], s[7 * 33]);
        *(u32x4*)(WT + (size_t)(drow0 + n) * ldd + k0 + 8 * c) = o; }
    LDS_WAIT();
}
__device__ __forceinline__ void phase_p0a(LAS unsigned char* lds, const Ptrs& P, int tid, int G) {
    unsigned char* ws = P.ws; const int wave = __builtin_amdgcn_readfirstlane(tid >> 6), lane = tid & 63, bid = blockIdx.x;
    for (int item = bid; item < 8 * 24; item += G) {
        const int kc = item / 24, nc = item % 24; LAS float* sl = (LAS float*)lds; LAS float* pl = (LAS float*)(lds + 2048);
        if (tid < 384) { const int g = tid >> 7, k = kc * 128 + (tid & 127); const float c = g == 0 ? P.c_ctx[k] : P.c[(size_t)(g - 1) * D + k]; sl[tid] = c * fsig(c); }
        __syncthreads();
        const int kh = tid >> 8, col = nc * 256 + (tid & 255); float a0 = 0.f, a1 = 0.f, a2 = 0.f;
        const float* wp = P.w_ada + (size_t)(kc * 128 + kh * 64) * MODW + col;
#pragma unroll 8
        for (int i = 0; i < 64; ++i) { const float w = wp[(size_t)i * MODW]; a0 += sl[kh * 64 + i] * w; a1 += sl[128 + kh * 64 + i] * w; a2 += sl[256 + kh * 64 + i] * w; }
        if (kh == 1) { pl[tid & 255] = a0; pl[256 + (tid & 255)] = a1; pl[512 + (tid & 255)] = a2; }
        __syncthreads();
        if (kh == 0) { float* mp = (float*)(ws + WS_MODP) + (size_t)kc * 3 * MODW + col; mp[0] = a0 + pl[tid]; mp[MODW] = a1 + pl[256 + tid]; mp[2 * MODW] = a2 + pl[512 + tid]; }
        __syncthreads();
    }
    LAS float* scr = (LAS float*)(lds + wave * 16384);
    const int gw = bid * NWAVES + wave, NGW = G * NWAVES;
    constexpr int I_IN = (D / 64) * (INC / 32), I_A = (DA / 64) * (D / 32), I_O = (D / 64) * (D / 32), I_FI = (D / 64) * (NFF2 / 32), I_FO = (DFF / 64) * (D / 32), I_PB = NH * 4 * (D / 32);
    constexpr int NITEMS = I_IN + I_A + I_O + I_FI + I_FO + I_PB;
    for (int it = gw; it < NITEMS; it += NGW) {
        int r = it;
        if (r < I_IN) { const int nb = INC / 32; transpose_item(P.w_in, INC, (bf16_t*)(ws + WS_WIN), D, 32 * (r % nb), 64 * (r / nb), 32 * (r % nb), scr, lane); continue; } r -= I_IN;
        if (r < I_A) { const int nb = D / 32; transpose_item(P.w_branch_a, D, (bf16_t*)(ws + WS_WCAT), 1024, 32 * (r % nb), 64 * (r / nb), 32 * (r % nb), scr, lane); continue; } r -= I_A;
        if (r < I_O) { const int nb = D / 32; transpose_item(P.w_out, D, (bf16_t*)(ws + WS_WOUT), D, 32 * (r % nb), 64 * (r / nb), 32 * (r % nb), scr, lane); continue; } r -= I_O;
        if (r < I_FI) { const int nb = NFF2 / 32, n0 = 32 * (r % nb), j0 = n0 < DFF ? n0 : n0 - DFF, dr = (j0 / 128) * 256 + (j0 % 128) + (n0 < DFF ? 0 : 128);
            transpose_item(P.w_ffn_in, NFF2, (bf16_t*)(ws + WS_WFFI), D, dr, 64 * (r / nb), n0, scr, lane); continue; } r -= I_FI;
        if (r < I_FO) { const int nb = D / 32; transpose_item(P.w_ffn_out, D, (bf16_t*)(ws + WS_WFFO), DFF, 32 * (r % nb), 64 * (r / nb), 32 * (r % nb), scr, lane); continue; } r -= I_FO;
        {
            const int g = r / (4 * 32), c0 = 32 * ((r / 32) & 3), n0 = 32 * (r & 31), rr = lane & 31, h2 = lane >> 5;
            f32x16 acc;
#pragma unroll
            for (int i = 0; i < 16; ++i) acc[i] = 0.f;
            const float* ap = P.pool_w + (size_t)(g * 128 + c0 + rr) * 128 + h2; const float* bp = P.w_branch_b + (size_t)(g * 128 + h2) * D + n0 + rr; const float* sp = P.pool_scale + g * 128 + h2;
#pragma unroll 8
            for (int s = 0; s < 64; ++s) acc = __builtin_amdgcn_mfma_f32_32x32x2f32(ap[2 * s], sp[2 * s] * bp[(size_t)(2 * s) * D], acc, 0, 0, 0);
            bf16_t* dst = (bf16_t*)(ws + WS_WCAT) + (size_t)(n0 + rr) * 1024 + 512 + g * 128 + c0 + 4 * h2;
#pragma unroll
            for (int q = 0; q < 4; ++q) { unsigned lo = cvtpk(acc[4 * q], acc[4 * q + 1]), hi = cvtpk(acc[4 * q + 2], acc[4 * q + 3]); *(unsigned long long*)(dst + 8 * q) = (unsigned long long)lo | ((unsigned long long)hi << 32); }
        }
    }
}

__device__ __forceinline__ void phase_p0b(LAS unsigned char* lds, const Ptrs& P, int tid, int G) {
    unsigned char* ws = P.ws; const int wave = __builtin_amdgcn_readfirstlane(tid >> 6), lane = tid & 63, bid = blockIdx.x;
    const float* mp = (const float*)(ws + WS_MODP);
    LAS float* T0 = (LAS float*)lds;
    LAS float* T1 = T0 + 3 * D;
    LAS float* T2 = T1 + 3 * D;
    for (int i = tid; i < 9 * D; i += NWAVES * 64) {
        const int which = i / (3 * D), g = (i / D) % 3, k = i % D, n = (which == 0 ? 0 : which == 1 ? D : 3 * D) + k;
        float s = P.b_ada[n];
#pragma unroll
        for (int kc = 0; kc < 8; ++kc) s += mp[(size_t)(kc * 3 + g) * MODW + n];
        (which == 0 ? T0 : which == 1 ? T1 : T2)[g * D + k] = which == 1 ? P.norm1_g[k] * (1.0f + s) : s;
    }
    for (int i = bid * NWAVES * 64 + tid; i < 3 * MODW; i += G * NWAVES * 64) {
        const int g = i / MODW, n = i % MODW;
        float s = P.b_ada[n];
#pragma unroll
        for (int kc = 0; kc < 8; ++kc) s += mp[(size_t)(kc * 3 + g) * MODW + n];
        ((float*)(ws + WS_MOD))[i] = s;
    }
    __syncthreads();
    const int gw = bid * NWAVES + wave, NGW = G * NWAVES;
    for (int m = gw; m < M; m += NGW) {
        const int g = grp_of_row(m); const f32x4* xr = (const f32x4*)xrow(P, m) + lane;
        f32x4 v[4]; float ss = 0.f;
#pragma unroll
        for (int j = 0; j < 4; ++j) { v[j] = xr[64 * j]; ss += (v[j][0] * v[j][0] + v[j][1] * v[j][1]) + (v[j][2] * v[j][2] + v[j][3] * v[j][3]); }
        const float rstd = rsqrtf(wave_sum(ss) * (1.0f / D) + EPS);
        unsigned long long* o8 = (unsigned long long*)((bf16_t*)(ws + WS_H1) + (size_t)m * D) + lane;
#pragma unroll
        for (int j = 0; j < 4; ++j) { const int k = 4 * lane + 256 * j; const f32x4 t1 = *(const LAS f32x4*)(T1 + g * D + k), t0 = *(const LAS f32x4*)(T0 + g * D + k);
            const unsigned lo = cvtpk(v[j][0] * rstd * t1[0] + t0[0], v[j][1] * rstd * t1[1] + t0[1]), hi = cvtpk(v[j][2] * rstd * t1[2] + t0[2], v[j][3] * rstd * t1[3] + t0[3]);
            o8[64 * j] = (unsigned long long)lo | ((unsigned long long)hi << 32); }
    }
    for (int n = gw; n < NFF2; n += NGW) {
        const bf16_t* w = (const bf16_t*)(ws + WS_WFFI) + (size_t)n * D; float a0 = 0.f, a1 = 0.f, a2 = 0.f;
#pragma unroll
        for (int j = 0; j < 2; ++j) { const int k = 8 * lane + 512 * j; float wf[8]; unpack8(*(const u32x4*)(w + k), wf);
#pragma unroll
            for (int e = 0; e < 8; ++e) { a0 += T2[k + e] * wf[e]; a1 += T2[D + k + e] * wf[e]; a2 += T2[2 * D + k + e] * wf[e]; } }
        a0 = wave_sum(a0); a1 = wave_sum(a1); a2 = wave_sum(a2);
        if (lane == 0) { float* b2 = (float*)(ws + WS_BIAS2); b2[n] = a0; b2[NFF2 + n] = a1; b2[2 * NFF2 + n] = a2; }
    }
}

__device__ __forceinline__ void phase_final(const Ptrs& P, int tid, int G) {
    const int wave = __builtin_amdgcn_readfirstlane(tid >> 6), lane = tid & 63, gw = blockIdx.x * NWAVES + wave, NGW = G * NWAVES;
    for (int m = gw; m < M; m += NGW) {
        f32x4* xr = (f32x4*)(P.out + (size_t)m * D) + lane; f32x4 v[4]; float ss = 0.f;
#pragma unroll
        for (int j = 0; j < 4; ++j) { v[j] = xr[64 * j]; ss += (v[j][0] * v[j][0] + v[j][1] * v[j][1]) + (v[j][2] * v[j][2] + v[j][3] * v[j][3]); }
        const float rstd = rsqrtf(wave_sum(ss) * (1.0f / D) + EPS);
#pragma unroll
        for (int j = 0; j < 4; ++j) { const f32x4 g = *((const f32x4*)P.final_g + lane + 64 * j); xr[64 * j] = (f32x4){v[j][0] * rstd * g[0], v[j][1] * rstd * g[1], v[j][2] * rstd * g[2], v[j][3] * rstd * g[3]}; }
    }
}

__device__ __forceinline__ unsigned off_b(unsigned row, unsigned ch) { return 256u * row + 16u * (ch ^ (((row & 3) << 2) | ((row >> 2) & 3))); }
__device__ __forceinline__ int crow(int i, int h) { return (i & 3) + 8 * (i >> 2) + 4 * h; }
__device__ __forceinline__ s16x4 ldtr(const LAS unsigned char* p) { return __builtin_bit_cast(s16x4, __builtin_amdgcn_ds_read_tr16_b64_v4i16((LAS v4i16_t*)p)); }
__device__ __forceinline__ bf16x8 cat8(s16x4 a, s16x4 b) { return (bf16x8){a[0], a[1], a[2], a[3], b[0], b[1], b[2], b[3]}; }
__device__ __forceinline__ bf16x8 packf8(const f32x16& x, int s) {
    u32x4 p; p.x = cvtpk(x[8 * s], x[8 * s + 1]); p.y = cvtpk(x[8 * s + 2], x[8 * s + 3]); p.z = cvtpk(x[8 * s + 4], x[8 * s + 5]); p.w = cvtpk(x[8 * s + 6], x[8 * s + 7]);
    return __builtin_bit_cast(bf16x8, p);
}
constexpr int SC_QT = 0, SC_KT = 8192, SC_VI = 16384, SC_LF = 24576, SC_ER = 40960, SC_EL = SC_ER + 512, SC_ELP = SC_EL + 512, SC_FAC = SC_ELP + 512, SC_GRP = SC_FAC + 512;
static_assert(2 * SC_GRP <= RING_BYTES, "scan LDS");
constexpr int N_SCAN_UNITS = BL * NH + BC * NH;

__device__ __forceinline__ void scan_unit(LAS unsigned char* lds, const Ptrs& P, int unit, int tid) {
    unsigned char* ws = P.ws;
    const int wave = __builtin_amdgcn_readfirstlane(tid >> 6), lane = tid & 63, dir = wave >> 2, w4 = wave & 3, gt = tid & 255, r_ = lane & 31, h2_ = lane >> 5;
    const bool ctx = unit >= BL * NH;
    int b, h, nch, row0;
    if (ctx) { const int v = unit - BL * NH; b = v >> 2; h = v & 3; nch = TC / 32; row0 = b * TC; } else { b = unit >> 2; h = unit & 3; nch = TL / 32; row0 = NCTX + b * TL; }
    LAS unsigned char* Gb = lds + dir * SC_GRP;
    LAS unsigned char* QT = Gb + SC_QT; LAS unsigned char* KT = Gb + SC_KT; LAS unsigned char* VI = Gb + SC_VI;
    LAS float* LF = (LAS float*)(Gb + SC_LF); LAS float* ER = (LAS float*)(Gb + SC_ER); LAS float* EL = (LAS float*)(Gb + SC_EL); LAS float* ELP = (LAS float*)(Gb + SC_ELP);
    LAS float* FAC = (LAS float*)(Gb + SC_FAC);
    const float* LOGF = (const float*)(ws + WS_LOGF) + dir * 512 + h * 128; const bf16_t* KKp = (const bf16_t*)(ws + WS_KK) + dir * 512 + h * 128;
    const bf16_t* Qp = (const bf16_t*)(ws + WS_Q) + h * 128; const bf16_t* Vp = (const bf16_t*)(ws + WS_V) + h * 128;
    float* OT = (float*)(ws + WS_OTMP) + h * 128 + 32 * w4;
    f32x16 S[4];
    {
        const float* sp = P.state + ((size_t)((b * 2 + dir) * 4 + h) * 128) * 128 + 32 * w4 + r_;
#pragma unroll
        for (int db = 0; db < 4; ++db)
#pragma unroll
            for (int i = 0; i < 16; ++i) S[db][i] = ctx ? 0.f : sp[(size_t)(32 * db + crow(i, h2_)) * 128];
    }
    if (gt < 128) ELP[gt] = 1.0f;
    const int it = gt >> 4, oct = gt & 15;
    u32x4 q8[2], k8[2], v8[2]; f32x4 lfa[2], lfb[2];
#define SC_LOAD_LF(chunk) do { _Pragma("unroll") for (int ii = 0; ii < 2; ++ii) { const size_t row = (size_t)(row0 + 32 * (chunk) + it + 16 * ii); \
        lfa[ii] = *(const f32x4*)(LOGF + row * 1024 + oct * 8); lfb[ii] = *(const f32x4*)(LOGF + row * 1024 + oct * 8 + 4); } } while (0)
#define SC_LOAD_QKV(chunk) do { _Pragma("unroll") for (int ii = 0; ii < 2; ++ii) { const size_t row = (size_t)(row0 + 32 * (chunk) + it + 16 * ii); \
        q8[ii] = *(const u32x4*)(Qp + row * 512 + oct * 8); k8[ii] = *(const u32x4*)(KKp + row * 1024 + oct * 8); v8[ii] = *(const u32x4*)(Vp + row * 512 + oct * 8); } } while (0)
    SC_LOAD_LF(dir ? nch - 1 : 0);
    for (int j = 0; j < nch; ++j) {
        const int chunk = dir ? nch - 1 - j : j;
        SC_LOAD_QKV(chunk);
#pragma unroll
        for (int ii = 0; ii < 2; ++ii) { const int t = it + 16 * ii;
            *(LAS f32x4*)(LF + t * 128 + oct * 8) = lfa[ii]; *(LAS f32x4*)(LF + t * 128 + oct * 8 + 4) = lfb[ii];
            }
        __syncthreads();
        {
            const int d = gt & 127, half = gt >> 7; float acc = 0.f;
            if (half == 0) {
#pragma unroll
                for (int t = 15; t >= 0; --t) { const float x = LF[t * 128 + d]; if (dir == 0) { LF[t * 128 + d] = -acc; acc += x; } else { acc += x; LF[t * 128 + d] = acc; } }
                if (dir == 0) ER[d] = __expf(acc); else EL[d] = __expf(acc);
            } else {
#pragma unroll
                for (int t = 16; t < 32; ++t) { const float x = LF[t * 128 + d]; if (dir == 0) { acc += x; LF[t * 128 + d] = acc; } else { LF[t * 128 + d] = -acc; acc += x; } }
                if (dir == 0) EL[d] = __expf(acc); else ER[d] = __expf(acc);
            }
        }
        __syncthreads();
#pragma unroll
        for (int ii = 0; ii < 2; ++ii) { const int t = it + 16 * ii;
            const f32x4 ca = *(const LAS f32x4*)(LF + t * 128 + oct * 8), cb = *(const LAS f32x4*)(LF + t * 128 + oct * 8 + 4);
            float qf[8], kf[8]; unpack8(q8[ii], qf); unpack8(k8[ii], kf);
            const float cc[8] = {ca[0], ca[1], ca[2], ca[3], cb[0], cb[1], cb[2], cb[3]};
#pragma unroll
            for (int e = 0; e < 8; ++e) { const float e1 = __expf(cc[e]), e2 = __expf(-cc[e]); qf[e] *= e1; kf[e] *= e2; }
            *(LAS u32x4*)(QT + off_b(t, oct)) = pack8(qf); *(LAS u32x4*)(KT + off_b(t, oct)) = pack8(kf); *(LAS u32x4*)(VI + off_b(t, oct)) = v8[ii]; }
        if (gt < 128) { const float el = EL[gt]; FAC[gt] = ER[gt] * ELP[gt]; ELP[gt] = el; }
        if (j + 1 < nch) SC_LOAD_LF(dir ? nch - 2 - j : j + 1);
        __syncthreads();
        int r = r_, h2 = h2_; asm volatile("" : "+v"(r), "+v"(h2));
#pragma unroll
        for (int db = 0; db < 4; ++db)
#pragma unroll
            for (int q = 0; q < 4; ++q) { const f32x4 f = *(const LAS f32x4*)(FAC + 32 * db + 8 * q + 4 * h2);
#pragma unroll
                for (int e = 0; e < 4; ++e) S[db][4 * q + e] *= f[e];
                if (q == 3) asm volatile("" ::: "memory"); }
        f32x16 X;
#pragma unroll
        for (int i = 0; i < 16; ++i) X[i] = 0.f;
#pragma unroll
        for (int ks = 0; ks < 8; ++ks) { const bf16x8 a = *(const LAS bf16x8*)(KT + off_b(r, 2 * ks + h2)), bq = *(const LAS bf16x8*)(QT + off_b(r, 2 * ks + h2));
            X = __builtin_amdgcn_mfma_f32_32x32x16_bf16(a, bq, X, 0, 0, 0); if (ks == 3) asm volatile("" ::: "memory"); }
        asm volatile("" ::: "memory");
#pragma unroll
        for (int i = 0; i < 16; ++i) { const int s = crow(i, h2); const bool keep = dir == 0 ? (s <= r) : (s >= r); X[i] = keep ? X[i] : 0.f; }
        f32x16 O;
#pragma unroll
        for (int i = 0; i < 16; ++i) O[i] = 0.f;
#pragma unroll
        for (int db = 0; db < 4; ++db)
#pragma unroll
            for (int s2 = 0; s2 < 2; ++s2) {
                const s16x4 lo = *(const LAS s16x4*)(QT + off_b(r, 4 * db + 2 * s2) + 8 * h2), hi = *(const LAS s16x4*)(QT + off_b(r, 4 * db + 2 * s2 + 1) + 8 * h2);
                O = __builtin_amdgcn_mfma_f32_32x32x16_bf16(cat8(lo, hi), packf8(S[db], s2), O, 0, 0, 0);
                if (s2 == 1 && (db & 1)) asm volatile("" ::: "memory");
            }
        {
            const int blk = (r >> 4) & 1, q = (r & 15) >> 2, p = r & 3;
#pragma unroll
            for (int s2 = 0; s2 < 2; ++s2) {
                const s16x4 lo = ldtr(VI + off_b(16 * s2 + 4 * h2 + q, 4 * w4 + 2 * blk + (p >> 1)) + 8 * (p & 1)), hi = ldtr(VI + off_b(16 * s2 + 8 + 4 * h2 + q, 4 * w4 + 2 * blk + (p >> 1)) + 8 * (p & 1));
                O = __builtin_amdgcn_mfma_f32_32x32x16_bf16(packf8(X, s2), cat8(lo, hi), O, 0, 0, 0);
            }
#pragma unroll
            for (int s2 = 0; s2 < 2; ++s2) {
                const s16x4 vlo = ldtr(VI + off_b(16 * s2 + 8 * h2 + q, 4 * w4 + 2 * blk + (p >> 1)) + 8 * (p & 1)), vhi = ldtr(VI + off_b(16 * s2 + 8 * h2 + 4 + q, 4 * w4 + 2 * blk + (p >> 1)) + 8 * (p & 1));
                const bf16x8 vb = cat8(vlo, vhi);
#pragma unroll
                for (int db = 0; db < 4; ++db) {
                    const s16x4 klo = ldtr(KT + off_b(16 * s2 + 8 * h2 + q, 4 * db + 2 * blk + (p >> 1)) + 8 * (p & 1)), khi = ldtr(KT + off_b(16 * s2 + 8 * h2 + 4 + q, 4 * db + 2 * blk + (p >> 1)) + 8 * (p & 1));
                    S[db] = __builtin_amdgcn_mfma_f32_32x32x16_bf16(cat8(klo, khi), vb, S[db], 0, 0, 0);
                }
                asm volatile("" ::: "memory");
            }
        }
        const size_t rbase = (size_t)(row0 + 32 * chunk);
        if (j < nch / 2) {
#pragma unroll
            for (int i = 0; i < 16; ++i) OT[(rbase + crow(i, h2)) * 512 + r] = O[i];
            VM_WAIT();
        } else {
#pragma unroll
            for (int i = 0; i < 16; ++i) LF[crow(i, h2) * 128 + 32 * w4 + r] = O[i];
            __syncthreads();
            const int t = gt >> 3, col = h * 128 + (gt & 7) * 16; const size_t row = rbase + t;
            const float* otp = (const float*)(ws + WS_OTMP) + row * 512 + col; float o[16]; float ss = 0.f;
#pragma unroll
            for (int q = 0; q < 4; ++q) { const f32x4 a = *(const LAS f32x4*)(LF + t * 128 + (gt & 7) * 16 + 4 * q), p = *(const f32x4*)(otp + 4 * q);
#pragma unroll
                for (int e = 0; e < 4; ++e) { o[4 * q + e] = a[e] + p[e]; ss += o[4 * q + e] * o[4 * q + e]; } }
            ss += __shfl_xor(ss, 1); ss += __shfl_xor(ss, 2); ss += __shfl_xor(ss, 4);
            const float rs = rsqrtf(ss * (1.0f / 128.0f) + EPS);
            const bf16_t* ogp = (const bf16_t*)(ws + WS_OG) + row * 512 + col; bf16_t* dst = (bf16_t*)(ws + WS_ACAT) + row * 1024 + col;
#pragma unroll
            for (int q = 0; q < 2; ++q) { float og[8], v[8]; unpack8(*(const u32x4*)(ogp + 8 * q), og);
                const f32x4 n0 = *(const f32x4*)(P.hgrn_norm_g + col + 8 * q), n1 = *(const f32x4*)(P.hgrn_norm_g + col + 8 * q + 4);
#pragma unroll
                for (int e = 0; e < 4; ++e) { v[e] = o[8 * q + e] * rs * n0[e] * og[e]; v[4 + e] = o[8 * q + 4 + e] * rs * n1[e] * og[4 + e]; }
                *(u32x4*)(dst + 8 * q) = pack8(v); }
        }
        __syncthreads();
    }
#undef SC_LOAD_LF
#undef SC_LOAD_QKV
    if (ctx) {
        int rf = r_, hf = h2_; asm volatile("" : "+v"(rf), "+v"(hf));
        float* ns = P.out + (size_t)M * D + ((size_t)((b * 2 + dir) * 4 + h) * 128) * 128 + 32 * w4 + rf;
#pragma unroll
        for (int db = 0; db < 4; ++db)
#pragma unroll
            for (int i = 0; i < 16; ++i) { const int d = 32 * db + crow(i, hf); ns[(size_t)d * 128] = S[db][i] * ELP[d]; }
    }
    __syncthreads();
}

__device__ __forceinline__ void pool_item(const Ptrs& P, int idx, int lane) {
    unsigned char* ws = P.ws; const bf16_t* Z = (const bf16_t*)(ws + WS_POOL);
    int g, quad;
    if (idx < 4 * (NLAT / 4)) { g = 3 - idx / (NLAT / 4); quad = NCTX / 4 + idx % (NLAT / 4); } else { const int v = idx - 4 * (NLAT / 4); g = v & 3; quad = v >> 2; }
    const int m = 4 * quad + (lane >> 4), c = g * 128 + 8 * (lane & 15), w = 2 << g, hw = w >> 1;
    float s[8];
#pragma unroll
    for (int e = 0; e < 8; ++e) s[e] = 0.f;
    int cnt = 0;
    if (m < NCTX) {
        const int b = m / TC, pos = m % TC;
        for (int dt = -hw; dt < hw; ++dt) { const int t = pos + dt; if (t >= 0 && t < TC) { float f[8]; unpack8(*(const u32x4*)(Z + (size_t)(b * TC + t) * DB + c), f); ++cnt;
#pragma unroll
                for (int e = 0; e < 8; ++e) s[e] += f[e]; } }
    } else {
        const int ml = m - NCTX, b = ml / TL, t = ml % TL, gr = t / GRID_W, gc = t % GRID_W;
        for (int dr = -hw; dr < hw; ++dr) { const int rr = gr + dr;
            for (int dc = -hw; dc < hw; ++dc) { const int c2 = gc + dc; if (rr >= 0 && rr < GRID_H && c2 >= 0 && c2 < GRID_W) { float f[8]; unpack8(*(const u32x4*)(Z + (size_t)(NCTX + b * TL + rr * GRID_W + c2) * DB + c), f); ++cnt;
#pragma unroll
                    for (int e = 0; e < 8; ++e) s[e] += f[e]; } } }
    }
    float x[8]; unpack8(*(const u32x4*)(Z + (size_t)m * DB + c), x); const float inv = 1.0f / (float)cnt;
#pragma unroll
    for (int e = 0; e < 8; ++e) s[e] = s[e] * inv - x[e];
    *(u32x4*)((bf16_t*)(ws + WS_ACAT) + (size_t)m * 1024 + 512 + c) = pack8(s);
}
__device__ __forceinline__ void phase_mixers(LAS unsigned char* lds, const Ptrs& P, int tid, int G) {
    const int bid = blockIdx.x, wave = __builtin_amdgcn_readfirstlane(tid >> 6), lane = tid & 63;
    if (G > N_SCAN_UNITS) {
        if (bid < N_SCAN_UNITS) scan_unit(lds, P, bid, tid);
        else { const int npw = (G - N_SCAN_UNITS) * NWAVES; for (int idx = (bid - N_SCAN_UNITS) * NWAVES + wave; idx < M; idx += npw) pool_item(P, idx, lane); }
    } else {
        for (int u = bid; u < N_SCAN_UNITS; u += G) scan_unit(lds, P, u, tid);
        for (int idx = bid * NWAVES + wave; idx < M; idx += G * NWAVES) pool_item(P, idx, lane);
    }
}
struct Args { Ptrs P; int ph_lo, ph_hi; };

__global__ void __launch_bounds__(NWAVES * 64, 2) mega(Args a) {
    extern __shared__ __attribute__((aligned(16))) unsigned char lds_raw[];
    LAS unsigned char* lds = (LAS unsigned char*)lds_raw;
    const Ptrs& P = a.P; unsigned char* ws = P.ws;
    const int tid = threadIdx.x, G = gridDim.x;
    for (int i = tid; i < (LDS_BYTES - LDSCTL_OFF) / 4; i += NWAVES * 64) ((LAS unsigned*)(lds + LDSCTL_OFF))[i] = 0u;
    __syncthreads();
    const int lo = a.ph_lo, hi = a.ph_hi;
    XcdBarrier bar; bar.bar = (unsigned*)(ws + WS_CTL) + CW_BAR; bar.x = 0; bar.st = nullptr;
    if (hi - lo > 1) bar = xcd_barrier_post((unsigned*)(ws + WS_CTL) + CW_BAR, (volatile LAS unsigned*)(lds + MISC_OFF) + 8);
#ifndef PHASE_MASK
#define PHASE_MASK 0x1FF
#endif
#define IN(k) ((((PHASE_MASK) >> (k)) & 1) && lo <= (k) && (k) < hi)
#define BOTH(k) (IN(k) && IN((k) + 1))

    if (IN(0)) { phase_p0a(lds, P, tid, G); if (BOTH(0)) xcd_barrier(bar); }
    if (IN(1)) { phase_p0b(lds, P, tid, G); if (BOTH(1)) xcd_barrier(bar); }
    if (IN(2)) {
        pg8::Gemm g{(const bf16_t*)(ws + WS_H1), (const bf16_t*)(ws + WS_WIN), M, INC, D}; pg8::StaticOrder S; S.init(M, INC, G, (int)blockIdx.x);
        EpiG1 E{ws, P.lb_logits};
        pg8::gemm_phase<EpiG1, pg8::StaticOrder, true, true>(lds, g, S, E);
        if (BOTH(2)) xcd_barrier(bar);
    }
    if (IN(3)) { phase_mixers(lds, P, tid, G); if (BOTH(3)) xcd_barrier(bar); }
    if (IN(4)) {
        pg8::Gemm g{(const bf16_t*)(ws + WS_ACAT), (const bf16_t*)(ws + WS_WCAT), M, D, 1024}; pg8::StaticOrder S; S.init(M, D, G, (int)blockIdx.x);
        EpiMerge E{ws};
        pg8::gemm_phase<EpiMerge, pg8::StaticOrder, false, true>(lds, g, S, E);
        if (BOTH(4)) xcd_barrier(bar);
    }
    if (IN(5)) {
        pg8::Gemm g{(const bf16_t*)(ws + WS_MERGED), (const bf16_t*)(ws + WS_WOUT), M, D, D}; pg8::StaticOrder S; S.init(M, D, G, (int)blockIdx.x);
        EpiWout E{P};
        pg8::gemm_phase<EpiWout, pg8::StaticOrder, false, true>(lds, g, S, E);
        if (BOTH(5)) xcd_barrier(bar);
    }
    if (IN(6)) {
        pg8::Gemm g{(const bf16_t*)(ws + WS_A2), (const bf16_t*)(ws + WS_WFFI), M, NFF2, D}; pg8::StaticOrder S; S.init(M, NFF2, G, (int)blockIdx.x);
        EpiFfnIn E{ws};
        pg8::gemm_phase<EpiFfnIn, pg8::StaticOrder, true, true>(lds, g, S, E);
        if (BOTH(6)) xcd_barrier(bar);
    }
    if (IN(7)) {
        pg8::Gemm g{(const bf16_t*)(ws + WS_ACT), (const bf16_t*)(ws + WS_WFFO), M, D, DFF}; pg8::StaticOrder S; S.init(M, D, G, (int)blockIdx.x);
        EpiFfnOut E{P};
        pg8::gemm_phase<EpiFfnOut, pg8::StaticOrder, false, true>(lds, g, S, E);
        if (BOTH(7)) xcd_barrier(bar);
    }
    if (IN(8)) phase_final(P, tid, G);
#undef IN
#undef BOTH
}

#ifndef FAST_MASK
#define FAST_MASK 0x1FF
#endif
#ifndef MAX_FUSE
#define MAX_FUSE 9
#endif
extern "C" void kernel_launch(void* const* d_in, const int* in_sizes, int n_in, void* d_out, int out_size, void* d_ws, size_t ws_size, hipStream_t stream) {
    static int grid = 0;
    if (grid == 0) {
        if (n_in != 20 || ws_size < WS_END || in_sizes[0] != NCTX * D || out_size != M * D + BC * 2 * NH * HD * HD) { fprintf(stderr, "kernel_launch: unexpected shapes (n_in %d, ws %zu); nothing launched\n", n_in, ws_size); grid = -1; return; }
        int dev = 0, cus = 0, per_cu = 0;
        if (hipGetDevice(&dev) != hipSuccess || hipDeviceGetAttribute(&cus, hipDeviceAttributeMultiprocessorCount, dev) != hipSuccess) { grid = -1; return; }
        if (hipFuncSetAttribute((const void*)mega, hipFuncAttributeMaxDynamicSharedMemorySize, LDS_BYTES) != hipSuccess) { fprintf(stderr, "kernel_launch: hipFuncSetAttribute failed\n"); grid = -1; return; }
        if (hipOccupancyMaxActiveBlocksPerMultiprocessor(&per_cu, (const void*)mega, NWAVES * 64, LDS_BYTES) != hipSuccess || per_cu < 1) { fprintf(stderr, "kernel_launch: occupancy query says %d blocks per CU\n", per_cu); per_cu = 1; }
        (void)hipGetLastError();
        grid = cus;
    }
    if (grid < 0) return;
    Ptrs P{};
    const float** pp = (const float**)&P;
    for (int i = 0; i < 20; ++i) pp[i] = (const float*)d_in[i];
    P.out = (float*)d_out; P.ws = (unsigned char*)d_ws;
    unsigned char* ws = P.ws;
    auto nb = [](size_t n, int t) { return (unsigned)((n + t - 1) / t); };
    (void)hipMemsetAsync(ws + WS_CTL, 0, CTL_ZERO_BYTES, stream);
    float* ofwd = (float*)(ws + WS_OTMP); float* obwd = (float*)(ws + WS_MERGED);
    int k = 0;
    while (k < N_PHASES) {
        if ((FAST_MASK >> k) & 1) {
            int e = k; while (e < N_PHASES && ((FAST_MASK >> e) & 1) && e - k < MAX_FUSE) ++e;
            Args a{}; a.P = P; a.ph_lo = k; a.ph_hi = e;
            hipLaunchKernelGGL(mega, dim3(grid), dim3(NWAVES * 64), LDS_BYTES, stream, a);
            k = e; continue;
        }
        switch (k) {
        case 0:
            ks_mod<<<nb(3 * MODW, 256), 256, 0, stream>>>(P);
            ks_convT<<<nb((size_t)D * INC, 256), 256, 0, stream>>>(P.w_in, D, INC, (bf16_t*)(ws + WS_WIN), D, 0, 0);
            ks_convT<<<nb((size_t)DA * D, 256), 256, 0, stream>>>(P.w_branch_a, DA, D, (bf16_t*)(ws + WS_WCAT), 1024, 0, 0);
            ks_wpb<<<nb((size_t)DB * D, 256), 256, 0, stream>>>(P);
            ks_convT<<<nb((size_t)D * D, 256), 256, 0, stream>>>(P.w_out, D, D, (bf16_t*)(ws + WS_WOUT), D, 0, 0);
            ks_convT<<<nb((size_t)D * NFF2, 256), 256, 0, stream>>>(P.w_ffn_in, D, NFF2, (bf16_t*)(ws + WS_WFFI), D, 0, 1);
            ks_convT<<<nb((size_t)DFF * D, 256), 256, 0, stream>>>(P.w_ffn_out, DFF, D, (bf16_t*)(ws + WS_WFFO), DFF, 0, 0);
            break;
        case 1:
            ks_h1<<<nb((size_t)M * 64, 256), 256, 0, stream>>>(P);
            ks_bias2<<<nb(3 * NFF2, 256), 256, 0, stream>>>(P);
            break;
        case 2:
            ks_gemm<EpiG1s><<<nb((size_t)(M / 32) * (INC / 32) * 64, 256), 256, 0, stream>>>((const bf16_t*)(ws + WS_H1), D, (const bf16_t*)(ws + WS_WIN), D, D, M, INC, EpiG1s{ws, P.lb_logits});
            break;
        case 3:
            ks_scan<<<BC * NH * 2 + BL * NH * 2, 128, 0, stream>>>(P, ofwd, obwd);
            ks_ofinal<<<nb((size_t)M * NH * 64, 256), 256, 0, stream>>>(P, ofwd, obwd);
            ks_pool<<<nb((size_t)M * DB, 256), 256, 0, stream>>>(P);
            break;
        case 4:
            ks_gemm<EpiMerges><<<nb((size_t)(M / 32) * (D / 32) * 64, 256), 256, 0, stream>>>((const bf16_t*)(ws + WS_ACAT), 1024, (const bf16_t*)(ws + WS_WCAT), 1024, 512, M, D, EpiMerges{ws});
            break;
        case 5:
            ks_gemm<EpiWouts><<<nb((size_t)(M / 32) * (D / 32) * 64, 256), 256, 0, stream>>>((const bf16_t*)(ws + WS_MERGED), 1024, (const bf16_t*)(ws + WS_WOUT), 1024, D, M, D, EpiWouts{P});
            ks_ss2<<<nb((size_t)M * 16, 256), 256, 0, stream>>>(P);
            break;
        case 6:
            ks_gemm<EpiFfnIns><<<nb((size_t)(M / 32) * (DFF / 32) * 64, 256), 256, 0, stream>>>((const bf16_t*)(ws + WS_A2), 1024, (const bf16_t*)(ws + WS_WFFI), 1024, D, M, DFF, EpiFfnIns{ws});
            break;
        case 7:
            ks_gemm<EpiFfnOuts><<<nb((size_t)(M / 32) * (D / 32) * 64, 256), 256, 0, stream>>>((const bf16_t*)(ws + WS_ACT), DFF, (const bf16_t*)(ws + WS_WFFO), DFF, DFF, M, D, EpiFfnOuts{P});
            break;
        case 8:
            ks_final<<<nb((size_t)M * 64, 256), 256, 0, stream>>>(P);
            break;
        }
        ++k;
    }
}
```

```cpp
#include <hip/hip_runtime.h>
#include <stdint.h>
#include <stdio.h>

typedef unsigned short bf16_t;
typedef short bf16x8 __attribute__((ext_vector_type(8)));
typedef float f32x4 __attribute__((ext_vector_type(4)));

constexpr int D = 1024;
constexpr int BC = 32, TC = 256, BL = 2, TL = 1024;
constexpr int NCTX = BC * TC, NLAT = BL * TL, M = NCTX + NLAT;
constexpr int DA = 512, NH = 4, HD = 128, DB = 512;
constexpr int INC = 5120, DFF = 2816, NFF2 = 2 * DFF;
constexpr int MODW = 6 * D;
constexpr int GRID_W = 64, GRID_H = TL / GRID_W;
constexpr float EPS = 1e-6f;

constexpr size_t MiB = 1u << 20;
constexpr size_t WS_CTL = 0;
constexpr size_t WS_MOD = 1 * MiB;
constexpr size_t WS_BIAS2 = 1 * MiB + 128 * 1024;
constexpr size_t WS_WIN = 2 * MiB;
constexpr size_t WS_WCAT = 12 * MiB;
constexpr size_t WS_WOUT = 14 * MiB;
constexpr size_t WS_WFFI = 16 * MiB;
constexpr size_t WS_WFFO = 27 * MiB;
constexpr size_t WS_H1 = 34 * MiB;
constexpr size_t WS_Q = 54 * MiB, WS_V = 64 * MiB, WS_OG = 74 * MiB, WS_POOL = 84 * MiB;
constexpr size_t WS_GA = 94 * MiB, WS_GB = 114 * MiB;
constexpr size_t WS_LOGF = 134 * MiB;
constexpr size_t WS_KK = 174 * MiB;
constexpr size_t WS_OTMP = 194 * MiB;
constexpr size_t WS_SS2 = 194 * MiB;
constexpr size_t WS_ACAT = 214 * MiB;
constexpr size_t WS_MERGED = 234 * MiB;
constexpr size_t WS_X1 = WS_LOGF;
constexpr size_t WS_A2 = WS_H1;
constexpr size_t WS_ACT = WS_Q;
constexpr size_t WS_END = 254 * MiB;

__device__ __forceinline__ float bf2f(bf16_t b) { return __uint_as_float(((unsigned)b) << 16); }
__device__ __forceinline__ bf16_t f2bf(float f) { unsigned u = __float_as_uint(f); u += 0x7fffu + ((u >> 16) & 1u); return (bf16_t)(u >> 16); }
__device__ __forceinline__ float sigmoidf_(float z) { return 1.0f / (1.0f + __expf(-z)); }
__device__ __forceinline__ int grp_of_row(int m) { return m < NCTX ? 0 : 1 + (m - NCTX) / TL; }
__device__ __forceinline__ float wave_sum(float v) {
#pragma unroll
    for (int o = 1; o < 64; o <<= 1) v += __shfl_xor(v, o);
    return v;
}

struct Ptrs {
    const float* x_prompt; const float* x_sample; const float* state; const float* c; const float* c_ctx; const float* w_ada; const float* b_ada;
    const float* norm1_g; const float* w_in; const float* lb_logits; const float* hgrn_norm_g; const float* w_branch_a; const float* pool_w;
    const float* pool_scale; const float* w_branch_b; const float* w_out; const float* norm2_g; const float* w_ffn_in; const float* w_ffn_out; const float* final_g;
    float* out; unsigned char* ws;
};
__device__ __forceinline__ const float* xrow(const Ptrs& P, int m) { return m < NCTX ? P.x_prompt + (size_t)m * D : P.x_sample + (size_t)(m - NCTX) * D; }

__global__ void ks_mod(Ptrs P) {
    const int i = blockIdx.x * blockDim.x + threadIdx.x; if (i >= 3 * MODW) return;
    const int g = i / MODW, n = i % MODW; const float* cv = g == 0 ? P.c_ctx : P.c + (size_t)(g - 1) * D;
    float s = 0.f;
    for (int k = 0; k < D; ++k) { const float c = cv[k]; s += (c * sigmoidf_(c)) * P.w_ada[(size_t)k * MODW + n]; }
    ((float*)(P.ws + WS_MOD))[i] = s + P.b_ada[n];
}
__global__ void ks_convT(const float* src, int K, int N, bf16_t* dst, int ldd, int koff, int mode) {
    const size_t i = (size_t)blockIdx.x * blockDim.x + threadIdx.x; if (i >= (size_t)K * N) return;
    const int k = (int)(i / N), n = (int)(i % N);
    int r = n;
    if (mode == 1) { const int j = n < DFF ? n : n - DFF; r = (j / 128) * 256 + (j % 128) + (n < DFF ? 0 : 128); }
    dst[(size_t)r * ldd + koff + k] = f2bf(src[i]);
}
__global__ void ks_wpb(Ptrs P) {
    const int i = blockIdx.x * blockDim.x + threadIdx.x; if (i >= DB * D) return;
    const int gc = i / D, n = i % D, g = gc / 128;
    float s = 0.f;
    for (int d = 0; d < 128; ++d) s += P.pool_w[(size_t)gc * 128 + d] * P.pool_scale[g * 128 + d] * P.w_branch_b[(size_t)(g * 128 + d) * D + n];
    ((bf16_t*)(P.ws + WS_WCAT))[(size_t)n * 1024 + 512 + gc] = f2bf(s);
}
__global__ void ks_h1(Ptrs P) {
    const int m = (blockIdx.x * blockDim.x + threadIdx.x) >> 6, lane = threadIdx.x & 63; if (m >= M) return;
    const float* xr = xrow(P, m); const float* mod = (const float*)(P.ws + WS_MOD) + (size_t)grp_of_row(m) * MODW;
    float ss = 0.f; for (int k = lane; k < D; k += 64) { const float v = xr[k]; ss += v * v; }
    const float rstd = rsqrtf(wave_sum(ss) * (1.0f / D) + EPS);
    bf16_t* h = (bf16_t*)(P.ws + WS_H1) + (size_t)m * D;
    for (int k = lane; k < D; k += 64) h[k] = f2bf((xr[k] * rstd * P.norm1_g[k]) * (1.0f + mod[D + k]) + mod[k]);
}
__global__ void ks_bias2(Ptrs P) {
    const int i = blockIdx.x * blockDim.x + threadIdx.x; if (i >= 3 * NFF2) return;
    const int g = i / NFF2, n = i % NFF2; const float* sh = (const float*)(P.ws + WS_MOD) + (size_t)g * MODW + 3 * D;
    const bf16_t* w = (const bf16_t*)(P.ws + WS_WFFI) + (size_t)n * D; float s = 0.f;
    for (int k = 0; k < D; ++k) s += sh[k] * bf2f(w[k]);
    ((float*)(P.ws + WS_BIAS2))[i] = s;
}

template <class Epi>
__global__ __launch_bounds__(256) void ks_gemm(const bf16_t* A, int lda, const bf16_t* Bt, int ldb, int K, int Mrows, int Nout, Epi E) {
    const int wave = (blockIdx.x * 256 + threadIdx.x) >> 6, lane = threadIdx.x & 63, row = lane & 15, quad = lane >> 4;
    const int tn_count = Nout / 32, tm = wave / tn_count, tn = wave % tn_count; if (tm >= Mrows / 32) return;
    const int j0 = tn * 32, b1 = Epi::brow1(j0), b2 = Epi::brow2(j0);
    f32x4 acc1[2][2], acc2[2][2];
#pragma unroll
    for (int i = 0; i < 2; ++i)
#pragma unroll
        for (int j = 0; j < 2; ++j) { acc1[i][j] = (f32x4){0.f, 0.f, 0.f, 0.f}; acc2[i][j] = (f32x4){0.f, 0.f, 0.f, 0.f}; }
    for (int k0 = 0; k0 < K; k0 += 32) {
        bf16x8 a[2], b[2];
#pragma unroll
        for (int i = 0; i < 2; ++i) a[i] = *(const bf16x8*)(A + (size_t)(tm * 32 + i * 16 + row) * lda + k0 + quad * 8);
#pragma unroll
        for (int j = 0; j < 2; ++j) b[j] = *(const bf16x8*)(Bt + (size_t)(b1 + j * 16 + row) * ldb + k0 + quad * 8);
#pragma unroll
        for (int i = 0; i < 2; ++i)
#pragma unroll
            for (int j = 0; j < 2; ++j) acc1[i][j] = __builtin_amdgcn_mfma_f32_16x16x32_bf16(a[i], b[j], acc1[i][j], 0, 0, 0);
        if (Epi::DUAL) {
#pragma unroll
            for (int i = 0; i < 2; ++i) a[i] = *(const bf16x8*)(A + (size_t)(tm * 32 + i * 16 + row) * lda + Epi::KOFF2 + k0 + quad * 8);
#pragma unroll
            for (int j = 0; j < 2; ++j) b[j] = *(const bf16x8*)(Bt + (size_t)(b2 + j * 16 + row) * ldb + Epi::KOFF2 + k0 + quad * 8);
#pragma unroll
            for (int i = 0; i < 2; ++i)
#pragma unroll
                for (int j = 0; j < 2; ++j) acc2[i][j] = __builtin_amdgcn_mfma_f32_16x16x32_bf16(a[i], b[j], acc2[i][j], 0, 0, 0);
        }
    }
#pragma unroll
    for (int i = 0; i < 2; ++i)
#pragma unroll
        for (int j = 0; j < 2; ++j)
#pragma unroll
            for (int r = 0; r < 4; ++r) E(tm * 32 + i * 16 + quad * 4 + r, j0 + j * 16 + row, acc1[i][j][r], acc2[i][j][r]);
}

struct EpiG1s {
    static constexpr bool DUAL = false; static constexpr int KOFF2 = 0;
    static __device__ __forceinline__ int brow1(int j0) { return j0; }
    static __device__ __forceinline__ int brow2(int j0) { return j0; }
    unsigned char* ws; const float* lbl;
    __device__ __forceinline__ void operator()(int m, int n, float v, float) const {
        if (n < 512) ((bf16_t*)(ws + WS_Q))[(size_t)m * 512 + n] = f2bf(v);
        else if (n < 1536) {
            const int dd = n - 512;
            const float lb = sigmoidf_(lbl[dd] - lbl[1024 + dd]);
            const float e = __expf(-v), sig = 1.0f / (1.0f + e), f = lb + (1.0f - lb) * sig;
            ((float*)(ws + WS_LOGF))[(size_t)m * 1024 + dd] = __logf(f);
            ((bf16_t*)(ws + WS_KK))[(size_t)m * 1024 + dd] = f2bf((1.0f - lb) * e * sig);
        }
        else if (n < 2048) ((bf16_t*)(ws + WS_V))[(size_t)m * 512 + n - 1536] = f2bf(v);
        else if (n < 2560) ((bf16_t*)(ws + WS_OG))[(size_t)m * 512 + n - 2048] = f2bf(v * sigmoidf_(v));
        else if (n < 3072) ((bf16_t*)(ws + WS_POOL))[(size_t)m * 512 + n - 2560] = f2bf(v);
        else if (n < 4096) ((bf16_t*)(ws + WS_GA))[(size_t)m * 1024 + n - 3072] = f2bf(sigmoidf_(v));
        else ((bf16_t*)(ws + WS_GB))[(size_t)m * 1024 + n - 4096] = f2bf(sigmoidf_(v));
    }
};
struct EpiMerges {
    static constexpr bool DUAL = true; static constexpr int KOFF2 = 512;
    static __device__ __forceinline__ int brow1(int j0) { return j0; }
    static __device__ __forceinline__ int brow2(int j0) { return j0; }
    unsigned char* ws;
    __device__ __forceinline__ void operator()(int m, int n, float v1, float v2) const {
        const float ga = bf2f(((const bf16_t*)(ws + WS_GA))[(size_t)m * 1024 + n]), gb = bf2f(((const bf16_t*)(ws + WS_GB))[(size_t)m * 1024 + n]);
        ((bf16_t*)(ws + WS_MERGED))[(size_t)m * 1024 + n] = f2bf(ga * v1 + gb * v2);
    }
};
struct EpiWouts {
    static constexpr bool DUAL = false; static constexpr int KOFF2 = 0;
    static __device__ __forceinline__ int brow1(int j0) { return j0; }
    static __device__ __forceinline__ int brow2(int j0) { return j0; }
    Ptrs P;
    __device__ __forceinline__ void operator()(int m, int n, float v, float) const {
        const float* mod = (const float*)(P.ws + WS_MOD) + (size_t)grp_of_row(m) * MODW;
        const float x1 = xrow(P, m)[n] + mod[2 * D + n] * v;
        ((float*)(P.ws + WS_X1))[(size_t)m * D + n] = x1;
        ((bf16_t*)(P.ws + WS_A2))[(size_t)m * D + n] = f2bf(x1 * P.norm2_g[n] * (1.0f + mod[4 * D + n]));
    }
};
__global__ void ks_ss2(Ptrs P) {
    const int i = blockIdx.x * blockDim.x + threadIdx.x; if (i >= M * 16) return;
    const float* x1 = (const float*)(P.ws + WS_X1) + (size_t)(i / 16) * D + (i % 16) * 64; float s = 0.f;
    for (int k = 0; k < 64; ++k) s += x1[k] * x1[k];
    ((float*)(P.ws + WS_SS2))[i] = s;
}
struct EpiFfnIns {
    static constexpr bool DUAL = true; static constexpr int KOFF2 = 0;
    static __device__ __forceinline__ int brow1(int j0) { return (j0 / 128) * 256 + (j0 % 128); }
    static __device__ __forceinline__ int brow2(int j0) { return (j0 / 128) * 256 + (j0 % 128) + 128; }
    unsigned char* ws;
    __device__ __forceinline__ void operator()(int m, int j, float v1, float v2) const {
        const float* ss = (const float*)(ws + WS_SS2) + (size_t)m * 16; float s = 0.f;
        for (int p = 0; p < 16; ++p) s += ss[p];
        const float rstd = rsqrtf(s * (1.0f / D) + EPS);
        const float* b2 = (const float*)(ws + WS_BIAS2) + (size_t)grp_of_row(m) * NFF2; const int n1 = (j / 128) * 256 + (j % 128);
        const float gv = v1 * rstd + b2[n1], uv = v2 * rstd + b2[n1 + 128];
        ((bf16_t*)(ws + WS_ACT))[(size_t)m * DFF + j] = f2bf(gv * sigmoidf_(gv) * uv);
    }
};
struct EpiFfnOuts {
    static constexpr bool DUAL = false; static constexpr int KOFF2 = 0;
    static __device__ __forceinline__ int brow1(int j0) { return j0; }
    static __device__ __forceinline__ int brow2(int j0) { return j0; }
    Ptrs P;
    __device__ __forceinline__ void operator()(int m, int n, float v, float) const {
        const float* mod = (const float*)(P.ws + WS_MOD) + (size_t)grp_of_row(m) * MODW;
        P.out[(size_t)m * D + n] = ((const float*)(P.ws + WS_X1))[(size_t)m * D + n] + mod[5 * D + n] * v;
    }
};
__global__ void ks_final(Ptrs P) {
    const int m = (blockIdx.x * blockDim.x + threadIdx.x) >> 6, lane = threadIdx.x & 63; if (m >= M) return;
    float* xr = P.out + (size_t)m * D; float v[16]; float ss = 0.f;
#pragma unroll
    for (int i = 0; i < 16; ++i) { v[i] = xr[lane + 64 * i]; ss += v[i] * v[i]; }
    const float rstd = rsqrtf(wave_sum(ss) * (1.0f / D) + EPS);
#pragma unroll
    for (int i = 0; i < 16; ++i) xr[lane + 64 * i] = v[i] * rstd * P.final_g[lane + 64 * i];
}

__global__ __launch_bounds__(128) void ks_scan(Ptrs P, float* ofwd, float* obwd) {
    __shared__ float fl[128], kl[128], ql[128];
    const int u = blockIdx.x, e = threadIdx.x;
    int b, h, dir, T, row0; const bool ctx = u < BC * NH * 2;
    if (ctx) { b = u / 8; h = (u >> 1) & 3; dir = u & 1; T = TC; row0 = b * TC; }
    else { const int v = u - BC * NH * 2; b = v / 8; h = (v >> 1) & 3; dir = v & 1; T = TL; row0 = NCTX + b * TL; }
    float S[128];
#pragma unroll
    for (int d = 0; d < 128; ++d) S[d] = ctx ? 0.f : P.state[((size_t)((b * 2 + dir) * 4 + h) * 128 + d) * 128 + e];
    const float* LOGF = (const float*)(P.ws + WS_LOGF); const bf16_t* KK = (const bf16_t*)(P.ws + WS_KK);
    const bf16_t* Q = (const bf16_t*)(P.ws + WS_Q); const bf16_t* V = (const bf16_t*)(P.ws + WS_V);
    float* o_out = dir ? obwd : ofwd;
    for (int step = 0; step < T; ++step) {
        const int t = dir ? T - 1 - step : step; const size_t row = (size_t)(row0 + t);
        fl[e] = __expf(LOGF[row * 1024 + dir * 512 + h * 128 + e]); kl[e] = bf2f(KK[row * 1024 + dir * 512 + h * 128 + e]); ql[e] = bf2f(Q[row * 512 + h * 128 + e]);
        const float v = bf2f(V[row * 512 + h * 128 + e]);
        __syncthreads();
        float o = 0.f;
#pragma unroll
        for (int d = 0; d < 128; ++d) { S[d] = fl[d] * S[d] + kl[d] * v; o += ql[d] * S[d]; }
        __syncthreads();
        o_out[row * 512 + h * 128 + e] = o;
    }
    if (ctx) {
        float* ns = P.out + (size_t)M * D + (size_t)((b * 2 + dir) * 4 + h) * 128 * 128;
#pragma unroll
        for (int d = 0; d < 128; ++d) ns[(size_t)d * 128 + e] = S[d];
    }
}
__global__ void ks_ofinal(Ptrs P, const float* ofwd, const float* obwd) {
    const int w = (blockIdx.x * blockDim.x + threadIdx.x) >> 6, lane = threadIdx.x & 63; if (w >= M * NH) return;
    const int m = w / NH, h = w % NH; const size_t base = (size_t)m * 512 + h * 128;
    const float o0 = ofwd[base + lane] + obwd[base + lane], o1 = ofwd[base + 64 + lane] + obwd[base + 64 + lane];
    const float r = rsqrtf(wave_sum(o0 * o0 + o1 * o1) * (1.0f / 128.0f) + EPS);
    const bf16_t* og = (const bf16_t*)(P.ws + WS_OG) + base; bf16_t* dst = (bf16_t*)(P.ws + WS_ACAT) + (size_t)m * 1024 + h * 128;
    dst[lane] = f2bf(o0 * r * P.hgrn_norm_g[h * 128 + lane] * bf2f(og[lane]));
    dst[64 + lane] = f2bf(o1 * r * P.hgrn_norm_g[h * 128 + 64 + lane] * bf2f(og[64 + lane]));
}
__global__ void ks_pool(Ptrs P) {
    const int i = blockIdx.x * blockDim.x + threadIdx.x; if (i >= M * DB) return;
    const int m = i / DB, c = i % DB, w = 2 << (c / 128); const bf16_t* Z = (const bf16_t*)(P.ws + WS_POOL);
    float s = 0.f; int cnt;
    if (m < NCTX) {
        const int b = m / TC, pos = m % TC; int lo = pos - w / 2, hi = pos + w / 2 - 1; lo = lo < 0 ? 0 : lo; hi = hi > TC - 1 ? TC - 1 : hi;
        for (int t = lo; t <= hi; ++t) s += bf2f(Z[(size_t)(b * TC + t) * DB + c]);
        cnt = hi - lo + 1;
    } else {
        const int ml = m - NCTX, b = ml / TL, t = ml % TL, r = t / GRID_W, cc = t % GRID_W;
        int rlo = r - w / 2, rhi = r + w / 2 - 1, clo = cc - w / 2, chi = cc + w / 2 - 1;
        rlo = rlo < 0 ? 0 : rlo; rhi = rhi > GRID_H - 1 ? GRID_H - 1 : rhi; clo = clo < 0 ? 0 : clo; chi = chi > GRID_W - 1 ? GRID_W - 1 : chi;
        for (int rr = rlo; rr <= rhi; ++rr) for (int c2 = clo; c2 <= chi; ++c2) s += bf2f(Z[(size_t)(NCTX + b * TL + rr * GRID_W + c2) * DB + c]);
        cnt = (rhi - rlo + 1) * (chi - clo + 1);
    }
    ((bf16_t*)(P.ws + WS_ACAT))[(size_t)m * 1024 + 512 + c] = f2bf(s / (float)cnt - bf2f(Z[(size_t)m * DB + c]));
}


namespace pg8 {
#define PG8_LAS __attribute__((address_space(3)))
typedef unsigned short bf16_t;
typedef short bf16x8 __attribute__((ext_vector_type(8)));
typedef float f32x4 __attribute__((ext_vector_type(4)));
typedef unsigned u32x4 __attribute__((ext_vector_type(4)));
constexpr int BM = 256, BK = 64, HALF = 128, HTB = HALF * BK * 2  , STAGE_BYTES = 8 * HTB, NXCD = 8, WGM = 8;

__host__ __device__ __forceinline__ int lds_byte(int r, int c) { const int st = (r >> 4) * 2 + (c >> 5), rr = r & 15, cc = c & 31, ob = rr * 64 + cc * 2; return st * 1024 + (ob ^ (((ob >> 9) & 1) << 5)); }
__host__ __device__ __forceinline__ void stage_rc(int b, int& R, int& C) { const int st = b / 1024, sb = b % 1024, swz = sb ^ (((sb >> 9) & 1) << 5); R = (st >> 1) * 16 + swz / 64; C = (st & 1) * 32 + (swz % 64) / 2; }
__host__ __device__ __forceinline__ int perm32(int rho) { const int n = rho >> 4, i = rho & 15; return 8 * (i >> 2) + 4 * n + (i & 3); }

struct Unit { int pm, pn; };
struct Gemm { const bf16_t* A; const bf16_t* Bt; int M, N, K; };

struct StaticOrder {
    int nM, nN, nwg, G, c;
    __host__ __device__ void init(int M, int N, int G_, int c_) { nM = M / BM; nN = N / BM; nwg = nM * nN; G = G_; c = c_; }
    __host__ __device__ bool next(int i, Unit& u) const {
        const long L = (long)i * G + c; if (L >= nwg) return false;
        int wgid = (int)L; { const int q = nwg / NXCD, r = nwg % NXCD, xcd = wgid % NXCD, off = wgid / NXCD; wgid = (xcd < r ? xcd * (q + 1) : r * (q + 1) + (xcd - r) * q) + off; }
        const int nig = WGM * nN, gid = wgid / nig, fm = gid * WGM, gsz = (nM - fm) < WGM ? (nM - fm) : WGM;
        u.pm = fm + ((wgid % nig) % gsz); u.pn = (wgid % nig) / gsz; return true;
    }
    __device__ __forceinline__ void a_ready(const Unit&) const {}
    __device__ __forceinline__ void done(const Unit&) const {}
};
template <class Epi, class Sched, bool ALIGN_EPI = false, bool SP2 = false>
__device__ __forceinline__ void gemm_phase(PG8_LAS unsigned char* lds, const Gemm g, const Sched& S, const Epi& E, int tid_in) {
    int tid = tid_in; asm volatile("" : "+v"(tid));
    const int wid = __builtin_amdgcn_readfirstlane(tid >> 6), lane = tid & 63, wr = wid >> 2, wc = wid & 3, fr = lane & 15, fq = lane >> 4;
    const int K = g.K, nt = K / BK;
    unsigned voffA[2], voffB[2];
#pragma unroll
    for (int i = 0; i < 2; ++i) { int R, C; stage_rc(tid * 16 + i * 8192, R, C); const int Rb = Epi::PERM ? ((R & ~31) + perm32(R & 31)) : R;
        voffA[i] = (unsigned)(R * K + C) * 2u; voffB[i] = (unsigned)(Rb * K + C) * 2u; }
    const size_t kstep = (size_t)(BK * 2);
    const size_t hstep = (size_t)HALF * K * 2;
    const size_t tstep = 2 * hstep;
    const unsigned ldsw = (unsigned)wid * 1024u;
    const int aoff = lds_byte(wr * 64 + fr, fq * 8), boff = lds_byte(wc * 32 + fr, fq * 8);
#define PG8_SA(b, h) (((b) * 2 + (h)) * HTB)
#define PG8_SB(b, h) ((4 + (b) * 2 + (h)) * HTB)
#define PG8_STAGE(bufoff, gbase, voff) do { _Pragma("unroll") for (int _i = 0; _i < 2; ++_i) \
        __builtin_amdgcn_global_load_lds((const unsigned*)((const char*)(gbase) + (voff)[_i]), (PG8_LAS unsigned*)(lds + (bufoff) + ldsw + _i * 8192), 16, 0, 0); } while (0)
#define PG8_LDA(dst, b, h) do { _Pragma("unroll") for (int m = 0; m < 4; ++m) _Pragma("unroll") for (int k = 0; k < 2; ++k) dst[m][k] = *(const PG8_LAS bf16x8*)(lds + PG8_SA(b, h) + aoff + m * 2048 + k * 1024); } while (0)
#define PG8_LDB(dst, b, h) do { _Pragma("unroll") for (int n = 0; n < 2; ++n) _Pragma("unroll") for (int k = 0; k < 2; ++k) dst[n][k] = *(const PG8_LAS bf16x8*)(lds + PG8_SB(b, h) + boff + n * 2048 + k * 1024); } while (0)
#define PG8_MMA(ai, bj, At, Bt) do { __builtin_amdgcn_s_setprio(1); _Pragma("unroll") for (int m = 0; m < 4; ++m) _Pragma("unroll") for (int n = 0; n < 2; ++n) _Pragma("unroll") for (int k = 0; k < 2; ++k) \
        acc[ai][bj][m][n] = __builtin_amdgcn_mfma_f32_16x16x32_bf16(Bt[n][k], At[m][k], acc[ai][bj][m][n], 0, 0, 0); __builtin_amdgcn_s_setprio(0); } while (0)
#define PG8_WAIT_V(n) asm volatile("s_waitcnt vmcnt(" #n ")" ::: "memory")
#define PG8_WAIT_L(n) asm volatile("s_waitcnt lgkmcnt(" #n ")" ::: "memory")
#define PG8_BAR __builtin_amdgcn_s_barrier()
#define PG8_SCHED __builtin_amdgcn_sched_barrier(0)
    Unit cur, nxt; int ui = 0;
    if (!S.next(0, cur)) return;
    f32x4 acc[2][2][4][2];
#pragma unroll
    for (int a = 0; a < 2; ++a)
#pragma unroll
        for (int b = 0; b < 2; ++b)
#pragma unroll
            for (int m = 0; m < 4; ++m)
#pragma unroll
                for (int n = 0; n < 2; ++n) acc[a][b][m][n] = (f32x4){0.f, 0.f, 0.f, 0.f};
    bf16x8 At[4][2], B0[2][2], B1[2][2];
    const char* cA = (const char*)g.A + (size_t)cur.pm * tstep; const char* cB = (const char*)g.Bt + (size_t)cur.pn * tstep;
    S.a_ready(cur);
    if constexpr (SP2) {
        PG8_STAGE(PG8_SB(0, 0), cB, voffB); PG8_STAGE(PG8_SB(0, 1), cB + hstep, voffB); PG8_STAGE(PG8_SA(0, 0), cA, voffA); PG8_STAGE(PG8_SA(0, 1), cA + hstep, voffA);
        if (wr == 1) PG8_BAR;
        PG8_WAIT_V(2); PG8_BAR;
        PG8_STAGE(PG8_SB(1, 0), cB + kstep, voffB); PG8_STAGE(PG8_SA(1, 0), cA + kstep, voffA); PG8_STAGE(PG8_SB(1, 1), cB + hstep + kstep, voffB);
        PG8_WAIT_V(6); PG8_BAR;
    } else {
        PG8_STAGE(PG8_SB(0, 0), cB, voffB); PG8_STAGE(PG8_SA(0, 0), cA, voffA); PG8_STAGE(PG8_SB(0, 1), cB + hstep, voffB); PG8_STAGE(PG8_SA(0, 1), cA + hstep, voffA);
        if (wr == 1) PG8_BAR;
        PG8_WAIT_V(4); PG8_BAR;
        PG8_STAGE(PG8_SB(1, 0), cB + kstep, voffB); PG8_STAGE(PG8_SA(1, 0), cA + kstep, voffA); PG8_STAGE(PG8_SB(1, 1), cB + hstep + kstep, voffB);
        PG8_WAIT_V(6); PG8_BAR;
    }
    for (;;) {
        const bool has_next = S.next(ui + 1, nxt);
        const char* nA = has_next ? (const char*)g.A + (size_t)nxt.pm * tstep : cA; const char* nB = has_next ? (const char*)g.Bt + (size_t)nxt.pn * tstep : cB;
        for (int t = 0; t < nt; t += 2) {
            const bool last = (t == nt - 2);
            const char* a1 = cA + (size_t)(t + 1) * kstep;
            const char* a2 = last ? nA : cA + (size_t)(t + 2) * kstep; const char* b2 = last ? nB : cB + (size_t)(t + 2) * kstep;
            const char* a3 = a2 + kstep; const char* b3 = b2 + kstep;
            if constexpr (Epi::MID) { if (t == (nt >> 1)) E.mid(acc, cur, wr, wc, fr, fq); }
            if (last && has_next) S.a_ready(nxt);
            if constexpr (SP2) {
            PG8_LDB(B0, 0, 0); PG8_LDB(B1, 0, 1); PG8_SCHED; PG8_LDA(At, 0, 0); PG8_STAGE(PG8_SA(1, 1), a1 + hstep, voffA);
            PG8_WAIT_V(8); PG8_WAIT_L(0); PG8_BAR; PG8_MMA(0, 0, At, B0); PG8_MMA(0, 1, At, B1); PG8_BAR; PG8_SCHED;
            PG8_LDA(At, 0, 1); PG8_STAGE(PG8_SB(0, 0), b2, voffB); PG8_STAGE(PG8_SB(0, 1), b2 + hstep, voffB); PG8_STAGE(PG8_SA(0, 0), a2, voffA);
            PG8_WAIT_V(8); PG8_WAIT_L(0); PG8_BAR; PG8_MMA(1, 0, At, B0); PG8_MMA(1, 1, At, B1); PG8_BAR; PG8_SCHED;
            PG8_LDB(B0, 1, 0); PG8_LDB(B1, 1, 1); PG8_SCHED; PG8_LDA(At, 1, 0); PG8_STAGE(PG8_SA(0, 1), a2 + hstep, voffA);
            PG8_WAIT_V(8); PG8_WAIT_L(0); PG8_BAR; PG8_MMA(0, 0, At, B0); PG8_MMA(0, 1, At, B1); PG8_BAR; PG8_SCHED;
            PG8_LDA(At, 1, 1); PG8_STAGE(PG8_SB(1, 0), b3, voffB); PG8_STAGE(PG8_SB(1, 1), b3 + hstep, voffB); PG8_STAGE(PG8_SA(1, 0), a3, voffA);
            PG8_WAIT_V(8); PG8_WAIT_L(0); PG8_BAR; PG8_MMA(1, 0, At, B0); PG8_MMA(1, 1, At, B1); PG8_BAR; PG8_SCHED;
            } else {
            PG8_LDB(B0, 0, 0); PG8_SCHED; PG8_LDA(At, 0, 0); PG8_STAGE(PG8_SA(1, 1), a1 + hstep, voffA);
            PG8_WAIT_L(8); PG8_BAR; PG8_WAIT_L(0); PG8_MMA(0, 0, At, B0); PG8_BAR; PG8_SCHED;
            PG8_LDB(B1, 0, 1); PG8_STAGE(PG8_SB(0, 0), b2, voffB);
            PG8_BAR; PG8_WAIT_L(0); PG8_MMA(0, 1, At, B1); PG8_BAR;
            PG8_LDA(At, 0, 1); PG8_STAGE(PG8_SA(0, 0), a2, voffA);
            PG8_BAR; PG8_WAIT_L(0); PG8_MMA(1, 0, At, B0); PG8_BAR; PG8_SCHED;
            PG8_STAGE(PG8_SB(0, 1), b2 + hstep, voffB);
            PG8_WAIT_V(6); PG8_BAR; PG8_MMA(1, 1, At, B1); PG8_BAR;
            PG8_LDB(B0, 1, 0); PG8_SCHED; PG8_LDA(At, 1, 0); PG8_STAGE(PG8_SA(0, 1), a2 + hstep, voffA);
            PG8_WAIT_L(8); PG8_BAR; PG8_WAIT_L(0); PG8_MMA(0, 0, At, B0); PG8_BAR; PG8_SCHED;
            PG8_LDB(B1, 1, 1); PG8_STAGE(PG8_SB(1, 0), b3, voffB);
            PG8_BAR; PG8_WAIT_L(0); PG8_MMA(0, 1, At, B1); PG8_BAR;
            PG8_LDA(At, 1, 1); PG8_STAGE(PG8_SA(1, 0), a3, voffA);
            PG8_BAR; PG8_WAIT_L(0); PG8_MMA(1, 0, At, B0); PG8_BAR; PG8_SCHED;
            PG8_STAGE(PG8_SB(1, 1), b3 + hstep, voffB);
            PG8_WAIT_V(6); PG8_BAR; PG8_MMA(1, 1, At, B1); PG8_BAR;
            }
        }
        if constexpr (ALIGN_EPI) { if (wr == 0) PG8_BAR; }
        if constexpr (!Epi::AFTER_DRAIN) { E(acc, cur, wr, wc, fr, fq); S.done(cur); }
        if (!has_next) break;
#pragma unroll
        for (int a = 0; a < 2; ++a)
#pragma unroll
            for (int b = 0; b < 2; ++b)
#pragma unroll
                for (int m = 0; m < 4; ++m)
#pragma unroll
                    for (int n = 0; n < 2; ++n) acc[a][b][m][n] = (f32x4){0.f, 0.f, 0.f, 0.f};
        cur = nxt; cA = nA; cB = nB; ++ui;
        if constexpr (ALIGN_EPI) { if (wr == 1) PG8_BAR; }
    }
    PG8_WAIT_V(0);
    if constexpr (!ALIGN_EPI) { if (wr == 0) PG8_BAR; }
    PG8_BAR;
    if constexpr (Epi::AFTER_DRAIN) { E.fused(acc, cur, wr, wc, fr, fq, lds, wid, lane); S.done(cur); }
#undef PG8_SA
#undef PG8_SB
#undef PG8_STAGE
#undef PG8_LDA
#undef PG8_LDB
#undef PG8_MMA
#undef PG8_WAIT_V
#undef PG8_WAIT_L
#undef PG8_BAR
#undef PG8_SCHED
}
}

#define LAS __attribute__((address_space(3)))
#define RLX_AGENT __ATOMIC_RELAXED, __HIP_MEMORY_SCOPE_AGENT
#define XB_TMO      128
#define XB_XCNT(j)  (256  + 64 * (j))
#define XB_XSUB(j)  (1280 + 64 * (j))
#define XB_XGEN(j)  (2304 + 64 * (j))
#define XB_TOP      3328
#define XB_TOPGEN   3392
#define XCD_BAR_WORDS 3456
#define XB_SPIN_CAP (1u << 18)

__device__ __forceinline__ unsigned xb_ld(unsigned* p)              { return __hip_atomic_load(p, __ATOMIC_RELAXED, __HIP_MEMORY_SCOPE_AGENT); }
__device__ __forceinline__ unsigned xb_add(unsigned* p, unsigned v) { return __hip_atomic_fetch_add(p, v, __ATOMIC_RELAXED, __HIP_MEMORY_SCOPE_AGENT); }
__device__ __forceinline__ unsigned xb_xcc_id() { return (unsigned)__builtin_amdgcn_s_getreg((3 << 11) | 20) & 0xFu; }
#define XB_SPIN(cond, bar) do { unsigned _sp = 0; while (cond) { __builtin_amdgcn_s_sleep(1); \
    if ((++_sp & 255u) == 0u) { if (xb_ld(&(bar)[XB_TMO])) break; if (_sp > XB_SPIN_CAP) { atomicAdd(&(bar)[XB_TMO], 1u); break; } } } } while (0)

struct XcdBarrier {
    unsigned* bar; unsigned x;
    volatile LAS unsigned* st;
    bool leader;
};

__device__ __forceinline__ XcdBarrier xcd_barrier_post(unsigned* bar, volatile LAS unsigned* st, int tid) {
    XcdBarrier b; b.bar = bar; b.x = xb_xcc_id(); b.st = st; b.leader = (tid == 0);
    if (b.leader) (void)xb_add(&bar[XB_XCNT(b.x)], 1u);
    return b;
}
__device__ __forceinline__ void xcd_barrier_complete(unsigned* bar, unsigned x, unsigned& nloc, unsigned& nx) {
    const unsigned G = gridDim.x * gridDim.y * gridDim.z;
    unsigned sum, cnt, mine, sp = 0u;
    for (;;) {
        sum = 0u; cnt = 0u; mine = 0u;
#pragma unroll
        for (unsigned j = 0; j < 16; ++j) { const unsigned c = xb_ld(&bar[XB_XCNT(j)]); sum += c; cnt += (c > 0u) ? 1u : 0u; mine = (j == x) ? c : mine; }
        if (sum == G) break;
        __builtin_amdgcn_s_sleep(1);
        if ((++sp & 255u) == 0u) { if (xb_ld(&bar[XB_TMO])) break; if (sp > XB_SPIN_CAP) { atomicAdd(&bar[XB_TMO], 1u); break; } }
    }
    nloc = mine > 0u ? mine : 1u; nx = cnt > 0u ? cnt : 1u;
}

__device__ __forceinline__ void xcd_barrier(const XcdBarrier& b) {
    asm volatile("s_waitcnt vmcnt(0)" ::: "memory");
    __syncthreads();
    if (b.leader) {
        unsigned* bar = b.bar;
        __builtin_amdgcn_s_waitcnt(0);
        unsigned nloc = b.st[0], nx = b.st[1];
        if (nloc == 0u) { xcd_barrier_complete(bar, b.x, nloc, nx); b.st[0] = nloc; b.st[1] = nx; }
        const unsigned old = xb_add(&bar[XB_XSUB(b.x)], 1u);
        const unsigned gen = old / nloc;
        if (old + 1u == (gen + 1u) * nloc) {
            __builtin_amdgcn_fence(__ATOMIC_RELEASE, "agent");
            asm volatile("s_waitcnt vmcnt(0)" ::: "memory");
            const unsigned og = xb_add(&bar[XB_TOP], 1u);
            const unsigned tg = og / nx;
            if (og + 1u == (tg + 1u) * nx) xb_add(&bar[XB_TOPGEN], 1u);
            else XB_SPIN(xb_ld(&bar[XB_TOPGEN]) == tg, bar);
            __builtin_amdgcn_fence(__ATOMIC_ACQUIRE, "agent");
            xb_add(&bar[XB_XGEN(b.x)], 1u);
            asm volatile("s_waitcnt vmcnt(0)" ::: "memory");
        } else {
            XB_SPIN(xb_ld(&bar[XB_XGEN(b.x)]) == gen, bar);
            __builtin_amdgcn_fence(__ATOMIC_ACQUIRE, "agent");
            asm volatile("s_waitcnt vmcnt(0)" ::: "memory");
        }
    }
    __syncthreads();
}

typedef unsigned u32x4 __attribute__((ext_vector_type(4)));
typedef float f32x2_t __attribute__((ext_vector_type(2)));
typedef __bf16 bf16x2_t __attribute__((ext_vector_type(2)));
__device__ __forceinline__ unsigned cvtpk(float lo, float hi) { f32x2_t v = {lo, hi}; bf16x2_t b = __builtin_convertvector(v, bf16x2_t); return __builtin_bit_cast(unsigned, b); }
__device__ __forceinline__ u32x4 pack8(const float* v) { u32x4 w; w.x = cvtpk(v[0], v[1]); w.y = cvtpk(v[2], v[3]); w.z = cvtpk(v[4], v[5]); w.w = cvtpk(v[6], v[7]); return w; }
__device__ __forceinline__ void unpack8(const u32x4 w, float* f) {
    f[0] = __uint_as_float(w.x << 16); f[1] = __uint_as_float(w.x & 0xffff0000u); f[2] = __uint_as_float(w.y << 16); f[3] = __uint_as_float(w.y & 0xffff0000u);
    f[4] = __uint_as_float(w.z << 16); f[5] = __uint_as_float(w.z & 0xffff0000u); f[6] = __uint_as_float(w.w << 16); f[7] = __uint_as_float(w.w & 0xffff0000u);
}
__device__ __forceinline__ float fsig(float z) { return __builtin_amdgcn_rcpf(1.0f + __expf(-z)); }
__device__ __forceinline__ int grp_of_pm(int pm) { return pm < NCTX / 256 ? 0 : 1 + (pm - NCTX / 256) / (TL / 256); }
#define ACC8(v, a) do { v[0] = a[0][0]; v[1] = a[0][1]; v[2] = a[0][2]; v[3] = a[0][3]; v[4] = a[1][0]; v[5] = a[1][1]; v[6] = a[1][2]; v[7] = a[1][3]; } while (0)

struct EpiG1 {
    static constexpr bool PERM = true, AFTER_DRAIN = false, MID = false;
    unsigned char* ws; const float* lbl; int pn_off;
    __device__ __forceinline__ void operator()(const f32x4 (&acc)[2][2][4][2], const pg8::Unit& u, int wr, int wc, int fr, int fq) const {
        const int row0 = u.pm * 256 + wr * 64 + fr, cl = wc * 32 + 8 * fq, pn = u.pn + pn_off;
        if (pn >= 2 && pn < 6) {
#pragma unroll
            for (int bj = 0; bj < 2; ++bj) {
                const int dd = (pn - 2) * 256 + bj * 128 + cl;
                float oml[8], lb[8];
#pragma unroll
                for (int e = 0; e < 8; ++e) { lb[e] = fsig(lbl[dd + e] - lbl[1024 + dd + e]); oml[e] = 1.0f - lb[e]; }
#pragma unroll
                for (int ai = 0; ai < 2; ++ai)
#pragma unroll
                    for (int m = 0; m < 4; ++m) {
                        const size_t row = (size_t)(row0 + ai * 128 + m * 16);
                        float v[8], lf[8], kk[8]; ACC8(v, acc[ai][bj][m]);
#pragma unroll
                        for (int e = 0; e < 8; ++e) { const float ex = __expf(fminf(-v[e], 80.0f)), sig = __builtin_amdgcn_rcpf(1.0f + ex); lf[e] = __logf(lb[e] + oml[e] * sig); kk[e] = oml[e] * ex * sig; }
                        float* lp = (float*)(ws + WS_LOGF) + row * 1024 + dd;
                        *(f32x4*)lp = (f32x4){lf[0], lf[1], lf[2], lf[3]}; *(f32x4*)(lp + 4) = (f32x4){lf[4], lf[5], lf[6], lf[7]};
                        *(u32x4*)((bf16_t*)(ws + WS_KK) + row * 1024 + dd) = pack8(kk);
                    }
            }
        } else {
            bf16_t* dst; int ldc, c0, act;
            if (pn < 2) { dst = (bf16_t*)(ws + WS_Q); ldc = 512; c0 = pn * 256; act = 0; }
            else if (pn < 8) { dst = (bf16_t*)(ws + WS_V); ldc = 512; c0 = (pn - 6) * 256; act = 0; }
            else if (pn < 10) { dst = (bf16_t*)(ws + WS_OG); ldc = 512; c0 = (pn - 8) * 256; act = 1; }
            else if (pn < 12) { dst = (bf16_t*)(ws + WS_POOL); ldc = 512; c0 = (pn - 10) * 256; act = 0; }
            else if (pn < 16) { dst = (bf16_t*)(ws + WS_GA); ldc = 1024; c0 = (pn - 12) * 256; act = 2; }
            else { dst = (bf16_t*)(ws + WS_GB); ldc = 1024; c0 = (pn - 16) * 256; act = 2; }
#pragma unroll
            for (int ai = 0; ai < 2; ++ai)
#pragma unroll
                for (int m = 0; m < 4; ++m) {
                    bf16_t* rowp = dst + (size_t)(row0 + ai * 128 + m * 16) * ldc + c0 + cl;
#pragma unroll
                    for (int bj = 0; bj < 2; ++bj) {
                        float v[8]; ACC8(v, acc[ai][bj][m]);
                        if (act != 0) {
#pragma unroll
                            for (int e = 0; e < 8; ++e) { const float s = fsig(v[e]); v[e] = act == 1 ? v[e] * s : s; }
                        }
                        *(u32x4*)(rowp + bj * 128) = pack8(v);
                    }
                }
        }
    }
};

struct EpiMerge {
    static constexpr bool PERM = true, AFTER_DRAIN = false, MID = true;
    unsigned char* ws;
    __device__ __forceinline__ void mid(f32x4 (&acc)[2][2][4][2], const pg8::Unit& u, int wr, int wc, int fr, int fq) const {
        int row0 = u.pm * 256 + wr * 64 + fr; const int col0 = u.pn * 256 + wc * 32 + 8 * fq;
        asm volatile("" : "+v"(row0));
#pragma unroll
        for (int ai = 0; ai < 2; ++ai)
#pragma unroll
            for (int m = 0; m < 4; ++m)
#pragma unroll
                for (int bj = 0; bj < 2; ++bj) {
                    const size_t off = (size_t)(row0 + ai * 128 + m * 16) * 1024 + col0 + bj * 128;
                    float ga[8], gb[8]; unpack8(*(const u32x4*)((const bf16_t*)(ws + WS_GA) + off), ga); unpack8(*(const u32x4*)((const bf16_t*)(ws + WS_GB) + off), gb);
#pragma unroll
                    for (int e = 0; e < 8; ++e) acc[ai][bj][m][e >> 2][e & 3] *= ga[e] * __builtin_amdgcn_rcpf(gb[e]);
                    asm volatile("" ::: "memory");
                }
    }
    __device__ __forceinline__ void operator()(const f32x4 (&acc)[2][2][4][2], const pg8::Unit& u, int wr, int wc, int fr, int fq) const {
        const int row0 = u.pm * 256 + wr * 64 + fr, col0 = u.pn * 256 + wc * 32 + 8 * fq;
#pragma unroll
        for (int ai = 0; ai < 2; ++ai)
#pragma unroll
            for (int m = 0; m < 4; ++m)
#pragma unroll
                for (int bj = 0; bj < 2; ++bj) {
                    const size_t off = (size_t)(row0 + ai * 128 + m * 16) * 1024 + col0 + bj * 128;
                    float gb[8], v[8]; unpack8(*(const u32x4*)((const bf16_t*)(ws + WS_GB) + off), gb); ACC8(v, acc[ai][bj][m]);
#pragma unroll
                    for (int e = 0; e < 8; ++e) v[e] *= gb[e];
                    *(u32x4*)((bf16_t*)(ws + WS_MERGED) + off) = pack8(v);
                }
    }
};

struct EpiWout {
    static constexpr bool PERM = true, AFTER_DRAIN = false, MID = false;
    Ptrs P;
    __device__ __forceinline__ void operator()(const f32x4 (&acc)[2][2][4][2], const pg8::Unit& u, int wr, int wc, int fr, int fq) const {
        const int row0 = u.pm * 256 + wr * 64 + fr, col0 = u.pn * 256 + wc * 32 + 8 * fq;
        const float* mod = (const float*)(P.ws + WS_MOD) + (size_t)grp_of_pm(u.pm) * MODW;
        float ss[2][4];
#pragma unroll
        for (int ai = 0; ai < 2; ++ai)
#pragma unroll
            for (int m = 0; m < 4; ++m) ss[ai][m] = 0.f;
#pragma unroll
        for (int bj = 0; bj < 2; ++bj) {
            const int col = col0 + bj * 128; float g1[8], g2s[8];
#pragma unroll
            for (int e = 0; e < 8; ++e) { g1[e] = mod[2 * D + col + e]; g2s[e] = P.norm2_g[col + e] * (1.0f + mod[4 * D + col + e]); }
#pragma unroll
            for (int ai = 0; ai < 2; ++ai)
#pragma unroll
                for (int m = 0; m < 4; ++m) {
                    const int row = row0 + ai * 128 + m * 16; const float* xr = xrow(P, row) + col;
                    const f32x4 xa = *(const f32x4*)xr, xb = *(const f32x4*)(xr + 4);
                    float v[8], a2[8]; ACC8(v, acc[ai][bj][m]);
                    const float xv[8] = {xa[0], xa[1], xa[2], xa[3], xb[0], xb[1], xb[2], xb[3]};
                    float s = 0.f;
#pragma unroll
                    for (int e = 0; e < 8; ++e) { v[e] = xv[e] + g1[e] * v[e]; s += v[e] * v[e]; a2[e] = v[e] * g2s[e]; }
                    ss[ai][m] += s;
                    float* x1p = (float*)(P.ws + WS_X1) + (size_t)row * D + col;
                    *(f32x4*)x1p = (f32x4){v[0], v[1], v[2], v[3]}; *(f32x4*)(x1p + 4) = (f32x4){v[4], v[5], v[6], v[7]};
                    *(u32x4*)((bf16_t*)(P.ws + WS_A2) + (size_t)row * D + col) = pack8(a2);
                }
        }
#pragma unroll
        for (int ai = 0; ai < 2; ++ai)
#pragma unroll
            for (int m = 0; m < 4; ++m) {
                float s = ss[ai][m]; s += __shfl_xor(s, 16); s += __shfl_xor(s, 32);
                if (fq == 0) ((float*)(P.ws + WS_SS2))[(size_t)(row0 + ai * 128 + m * 16) * 16 + u.pn * 4 + wc] = s;
            }
    }
};

struct EpiFfnIn {
    static constexpr bool PERM = true, AFTER_DRAIN = false, MID = false;
    unsigned char* ws;
    __device__ __forceinline__ void operator()(const f32x4 (&acc)[2][2][4][2], const pg8::Unit& u, int wr, int wc, int fr, int fq) const {
        const int row0 = u.pm * 256 + wr * 64 + fr, cl = wc * 32 + 8 * fq;
        const float* b2 = (const float*)(ws + WS_BIAS2) + (size_t)grp_of_pm(u.pm) * NFF2 + u.pn * 256 + cl;
        float bg[8], bu[8];
#pragma unroll
        for (int e = 0; e < 8; ++e) { bg[e] = b2[e]; bu[e] = b2[128 + e]; }
#pragma unroll
        for (int ai = 0; ai < 2; ++ai)
#pragma unroll
            for (int m = 0; m < 4; ++m) {
                const int row = row0 + ai * 128 + m * 16; const f32x4* sp = (const f32x4*)((const float*)(ws + WS_SS2) + (size_t)row * 16);
                const f32x4 s0 = sp[0], s1 = sp[1], s2 = sp[2], s3 = sp[3];
                float s = 0.f;
#pragma unroll
                for (int e = 0; e < 4; ++e) s += s0[e];
#pragma unroll
                for (int e = 0; e < 4; ++e) s += s1[e];
#pragma unroll
                for (int e = 0; e < 4; ++e) s += s2[e];
#pragma unroll
                for (int e = 0; e < 4; ++e) s += s3[e];
                const float rstd = rsqrtf(s * (1.0f / D) + EPS);
                float g[8], uu[8]; ACC8(g, acc[ai][0][m]); ACC8(uu, acc[ai][1][m]);
#pragma unroll
                for (int e = 0; e < 8; ++e) { const float gv = g[e] * rstd + bg[e], uv = uu[e] * rstd + bu[e]; g[e] = gv * fsig(gv) * uv; }
                *(u32x4*)((bf16_t*)(ws + WS_ACT) + (size_t)row * DFF + u.pn * 128 + cl) = pack8(g);
            }
    }
};

struct EpiFfnOut {
    static constexpr bool PERM = true, AFTER_DRAIN = false, MID = false;
    Ptrs P;
    __device__ __forceinline__ void operator()(const f32x4 (&acc)[2][2][4][2], const pg8::Unit& u, int wr, int wc, int fr, int fq) const {
        const int row0 = u.pm * 256 + wr * 64 + fr, col0 = u.pn * 256 + wc * 32 + 8 * fq;
        const float* mod = (const float*)(P.ws + WS_MOD) + (size_t)grp_of_pm(u.pm) * MODW + 5 * D;
#pragma unroll
        for (int bj = 0; bj < 2; ++bj) {
            const int col = col0 + bj * 128; float g2[8];
#pragma unroll
            for (int e = 0; e < 8; ++e) g2[e] = mod[col + e];
#pragma unroll
            for (int ai = 0; ai < 2; ++ai)
#pragma unroll
                for (int m = 0; m < 4; ++m) {
                    const size_t off = (size_t)(row0 + ai * 128 + m * 16) * D + col; const float* x1p = (const float*)(P.ws + WS_X1) + off;
                    const f32x4 xa = *(const f32x4*)x1p, xb = *(const f32x4*)(x1p + 4);
                    float v[8]; ACC8(v, acc[ai][bj][m]);
                    *(f32x4*)(P.out + off) = (f32x4){xa[0] + g2[0] * v[0], xa[1] + g2[1] * v[1], xa[2] + g2[2] * v[2], xa[3] + g2[3] * v[3]};
                    *(f32x4*)(P.out + off + 4) = (f32x4){xb[0] + g2[4] * v[4], xb[1] + g2[5] * v[5], xb[2] + g2[6] * v[6], xb[3] + g2[7] * v[7]};
                }
        }
    }
};


constexpr int NWAVES = 8;
constexpr int RING_BYTES = 131072, LDSCTL_OFF = RING_BYTES, MISC_OFF = LDSCTL_OFF + 320, LDS_BYTES = 147456;
constexpr int CW_BAR = 4096;
constexpr size_t CTL_ZERO_BYTES = 64 * 1024;
static_assert((CW_BAR + XCD_BAR_WORDS) * 4 <= (int)CTL_ZERO_BYTES, "barrier words inside the memset region");
constexpr int N_PHASES = 10;


typedef short s16x4 __attribute__((ext_vector_type(4)));
typedef short v4i16_t __attribute__((ext_vector_type(4)));
typedef float f32x16 __attribute__((ext_vector_type(16)));
#define LDS_WAIT() asm volatile("s_waitcnt lgkmcnt(0)" ::: "memory")
#define VM_WAIT() asm volatile("s_waitcnt vmcnt(0)" ::: "memory")
constexpr size_t WS_MODP = WS_ACAT;

__device__ __forceinline__ void transpose_item(const float* W, int N, bf16_t* WT, int ldd, int drow0, int k0, int n0, LAS float* scr, int lane) {
#pragma unroll 8
    for (int i = 0; i < 32; ++i) { const int kk = 2 * i + (lane >> 5); scr[kk * 33 + (lane & 31)] = W[(size_t)(k0 + kk) * N + n0 + (lane & 31)]; }
    LDS_WAIT();
    const int c = lane & 7;
#pragma unroll
    for (int j = 0; j < 4; ++j) { const int n = (lane >> 3) + 8 * j; const LAS float* s = scr + (8 * c) * 33 + n;
        u32x4 o; o.x = cvtpk(s[0 * 33], s[1 * 33]); o.y = cvtpk(s[2 * 33], s[3 * 33]); o.z = cvtpk(s[4 * 33], s[5 * 33]); o.w = cvtpk(s[6 * 33], s[7 * 33]);
        *(u32x4*)(WT + (size_t)(drow0 + n) * ldd + k0 + 8 * c) = o; }
    LDS_WAIT();
}
constexpr int I_IN = (D / 64) * (INC / 32), I_A = (DA / 64) * (D / 32), I_PB = NH * 4 * (D / 32), I_O = (D / 64) * (D / 32), I_FI = (D / 64) * (NFF2 / 32), I_FO = (DFF / 64) * (D / 32);
constexpr int WI_IN = I_IN, WI_AB = WI_IN + I_A + I_PB, WI_ALL = WI_AB + I_O + I_FI + I_FO;
__device__ __forceinline__ void wcopy_item(const Ptrs& P, LAS float* scr, int lane, int it) {
    unsigned char* ws = P.ws; int r = it;
    if (r < I_IN) { const int nb = INC / 32; transpose_item(P.w_in, INC, (bf16_t*)(ws + WS_WIN), D, 32 * (r % nb), 64 * (r / nb), 32 * (r % nb), scr, lane); return; } r -= I_IN;
    if (r < I_A) { const int nb = D / 32; transpose_item(P.w_branch_a, D, (bf16_t*)(ws + WS_WCAT), 1024, 32 * (r % nb), 64 * (r / nb), 32 * (r % nb), scr, lane); return; } r -= I_A;
    if (r < I_PB) {
        const int g = r / (4 * 32), c0 = 32 * ((r / 32) & 3), n0 = 32 * (r & 31), rr = lane & 31, h2 = lane >> 5;
        f32x16 acc;
#pragma unroll
        for (int i = 0; i < 16; ++i) acc[i] = 0.f;
        const float* ap = P.pool_w + (size_t)(g * 128 + c0 + rr) * 128 + h2; const float* bp = P.w_branch_b + (size_t)(g * 128 + h2) * D + n0 + rr; const float* sp = P.pool_scale + g * 128 + h2;
#pragma unroll 8
        for (int s = 0; s < 64; ++s) acc = __builtin_amdgcn_mfma_f32_32x32x2f32(ap[2 * s], sp[2 * s] * bp[(size_t)(2 * s) * D], acc, 0, 0, 0);
        bf16_t* dst = (bf16_t*)(ws + WS_WCAT) + (size_t)(n0 + rr) * 1024 + 512 + g * 128 + c0 + 4 * h2;
#pragma unroll
        for (int q = 0; q < 4; ++q) { unsigned lo = cvtpk(acc[4 * q], acc[4 * q + 1]), hi = cvtpk(acc[4 * q + 2], acc[4 * q + 3]); *(unsigned long long*)(dst + 8 * q) = (unsigned long long)lo | ((unsigned long long)hi << 32); }
        return; } r -= I_PB;
    if (r < I_O) { const int nb = D / 32; transpose_item(P.w_out, D, (bf16_t*)(ws + WS_WOUT), D, 32 * (r % nb), 64 * (r / nb), 32 * (r % nb), scr, lane); return; } r -= I_O;
    if (r < I_FI) { const int nb = NFF2 / 32, n0 = 32 * (r % nb), j0 = n0 < DFF ? n0 : n0 - DFF, dr = (j0 / 128) * 256 + (j0 % 128) + (n0 < DFF ? 0 : 128);
        transpose_item(P.w_ffn_in, NFF2, (bf16_t*)(ws + WS_WFFI), D, dr, 64 * (r / nb), n0, scr, lane); return; } r -= I_FI;
    { const int nb = D / 32; transpose_item(P.w_ffn_out, D, (bf16_t*)(ws + WS_WFFO), DFF, 32 * (r % nb), 64 * (r / nb), 32 * (r % nb), scr, lane); }
}
__device__ __forceinline__ void phase_p0a(LAS unsigned char* lds, const Ptrs& P, int tid, int G) {
    unsigned char* ws = P.ws; const int wave = __builtin_amdgcn_readfirstlane(tid >> 6), lane = tid & 63, bid = blockIdx.x;
    for (int item = bid; item < 8 * 24; item += G) {
        const int kc = item / 24, nc = item % 24; LAS float* sl = (LAS float*)lds; LAS float* pl = (LAS float*)(lds + 2048);
        if (tid < 384) { const int g = tid >> 7, k = kc * 128 + (tid & 127); const float c = g == 0 ? P.c_ctx[k] : P.c[(size_t)(g - 1) * D + k]; sl[tid] = c * fsig(c); }
        __syncthreads();
        const int kh = tid >> 8, col = nc * 256 + (tid & 255); float a0 = 0.f, a1 = 0.f, a2 = 0.f;
        const float* wp = P.w_ada + (size_t)(kc * 128 + kh * 64) * MODW + col;
#pragma unroll 8
        for (int i = 0; i < 64; ++i) { const float w = wp[(size_t)i * MODW]; a0 += sl[kh * 64 + i] * w; a1 += sl[128 + kh * 64 + i] * w; a2 += sl[256 + kh * 64 + i] * w; }
        if (kh == 1) { pl[tid & 255] = a0; pl[256 + (tid & 255)] = a1; pl[512 + (tid & 255)] = a2; }
        __syncthreads();
        if (kh == 0) { float* mp = (float*)(ws + WS_MODP) + (size_t)kc * 3 * MODW + col; mp[0] = a0 + pl[tid]; mp[MODW] = a1 + pl[256 + tid]; mp[2 * MODW] = a2 + pl[512 + tid]; }
        __syncthreads();
    }
    for (int it = bid * NWAVES + wave; it < WI_IN; it += G * NWAVES) wcopy_item(P, (LAS float*)(lds + wave * 16384), lane, it);
}

__device__ __forceinline__ void phase_p0b(LAS unsigned char* lds, const Ptrs& P, int tid, int G) {
    unsigned char* ws = P.ws; const int wave = __builtin_amdgcn_readfirstlane(tid >> 6), lane = tid & 63, bid = blockIdx.x;
    const float* mp = (const float*)(ws + WS_MODP);
    LAS float* T0 = (LAS float*)lds;
    LAS float* T1 = T0 + 3 * D;
    for (int i = tid; i < 6 * D; i += NWAVES * 64) {
        const int which = i / (3 * D), g = (i / D) % 3, k = i % D, n = (which == 0 ? 0 : D) + k;
        float s = P.b_ada[n];
#pragma unroll
        for (int kc = 0; kc < 8; ++kc) s += mp[(size_t)(kc * 3 + g) * MODW + n];
        (which == 0 ? T0 : T1)[g * D + k] = which == 1 ? P.norm1_g[k] * (1.0f + s) : s;
    }
    for (int i = bid * NWAVES * 64 + tid; i < 3 * MODW; i += G * NWAVES * 64) {
        const int g = i / MODW, n = i % MODW;
        float s = P.b_ada[n];
#pragma unroll
        for (int kc = 0; kc < 8; ++kc) s += mp[(size_t)(kc * 3 + g) * MODW + n];
        ((float*)(ws + WS_MOD))[i] = s;
    }
    __syncthreads();
    const int gw = bid * NWAVES + wave, NGW = G * NWAVES;
    for (int m = gw; m < M; m += NGW) {
        const int g = grp_of_row(m); const f32x4* xr = (const f32x4*)xrow(P, m) + lane;
        f32x4 v[4]; float ss = 0.f;
#pragma unroll
        for (int j = 0; j < 4; ++j) { v[j] = xr[64 * j]; ss += (v[j][0] * v[j][0] + v[j][1] * v[j][1]) + (v[j][2] * v[j][2] + v[j][3] * v[j][3]); }
        const float rstd = rsqrtf(wave_sum(ss) * (1.0f / D) + EPS);
        unsigned long long* o8 = (unsigned long long*)((bf16_t*)(ws + WS_H1) + (size_t)m * D) + lane;
#pragma unroll
        for (int j = 0; j < 4; ++j) { const int k = 4 * lane + 256 * j; const f32x4 t1 = *(const LAS f32x4*)(T1 + g * D + k), t0 = *(const LAS f32x4*)(T0 + g * D + k);
            const unsigned lo = cvtpk(v[j][0] * rstd * t1[0] + t0[0], v[j][1] * rstd * t1[1] + t0[1]), hi = cvtpk(v[j][2] * rstd * t1[2] + t0[2], v[j][3] * rstd * t1[3] + t0[3]);
            o8[64 * j] = (unsigned long long)lo | ((unsigned long long)hi << 32); }
    }
}

__device__ __forceinline__ void bias2_rows(LAS unsigned char* lds, const Ptrs& P, int tid, int widx, int nw) {
    unsigned char* ws = P.ws; const int lane = tid & 63; LAS float* T2 = (LAS float*)lds;
    for (int i = tid; i < 3 * D; i += NWAVES * 64) T2[i] = ((const float*)(ws + WS_MOD))[(size_t)(i / D) * MODW + 3 * D + (i % D)];
    __syncthreads();
    for (int n = widx; n < NFF2; n += nw) {
        const bf16_t* w = (const bf16_t*)(ws + WS_WFFI) + (size_t)n * D; float a0 = 0.f, a1 = 0.f, a2 = 0.f;
#pragma unroll
        for (int j = 0; j < 2; ++j) { const int k = 8 * lane + 512 * j; float wf[8]; unpack8(*(const u32x4*)(w + k), wf);
#pragma unroll
            for (int e = 0; e < 8; ++e) { a0 += T2[k + e] * wf[e]; a1 += T2[D + k + e] * wf[e]; a2 += T2[2 * D + k + e] * wf[e]; } }
        a0 = wave_sum(a0); a1 = wave_sum(a1); a2 = wave_sum(a2);
        if (lane == 0) { float* b2 = (float*)(ws + WS_BIAS2); b2[n] = a0; b2[NFF2 + n] = a1; b2[2 * NFF2 + n] = a2; }
    }
    __syncthreads();
}

__device__ __forceinline__ void phase_final(const Ptrs& P, int tid, int G) {
    const int wave = __builtin_amdgcn_readfirstlane(tid >> 6), lane = tid & 63, gw = blockIdx.x * NWAVES + wave, NGW = G * NWAVES;
    for (int m = gw; m < M; m += NGW) {
        f32x4* xr = (f32x4*)(P.out + (size_t)m * D) + lane; f32x4 v[4]; float ss = 0.f;
#pragma unroll
        for (int j = 0; j < 4; ++j) { v[j] = xr[64 * j]; ss += (v[j][0] * v[j][0] + v[j][1] * v[j][1]) + (v[j][2] * v[j][2] + v[j][3] * v[j][3]); }
        const float rstd = rsqrtf(wave_sum(ss) * (1.0f / D) + EPS);
#pragma unroll
        for (int j = 0; j < 4; ++j) { const f32x4 g = *((const f32x4*)P.final_g + lane + 64 * j); xr[64 * j] = (f32x4){v[j][0] * rstd * g[0], v[j][1] * rstd * g[1], v[j][2] * rstd * g[2], v[j][3] * rstd * g[3]}; }
    }
}

__device__ __forceinline__ unsigned off_b(unsigned row, unsigned ch) { return 256u * row + 16u * (ch ^ (((row & 3) << 2) | ((row >> 2) & 3))); }
__device__ __forceinline__ int crow(int i, int h) { return (i & 3) + 8 * (i >> 2) + 4 * h; }
__device__ __forceinline__ s16x4 ldtr(const LAS unsigned char* p) { return __builtin_bit_cast(s16x4, __builtin_amdgcn_ds_read_tr16_b64_v4i16((LAS v4i16_t*)p)); }
__device__ __forceinline__ bf16x8 cat8(s16x4 a, s16x4 b) { return (bf16x8){a[0], a[1], a[2], a[3], b[0], b[1], b[2], b[3]}; }
__device__ __forceinline__ bf16x8 packf8(const f32x16& x, int s) {
    u32x4 p; p.x = cvtpk(x[8 * s], x[8 * s + 1]); p.y = cvtpk(x[8 * s + 2], x[8 * s + 3]); p.z = cvtpk(x[8 * s + 4], x[8 * s + 5]); p.w = cvtpk(x[8 * s + 6], x[8 * s + 7]);
    return __builtin_bit_cast(bf16x8, p);
}
__device__ __forceinline__ unsigned off_a(unsigned row, unsigned ch) { return 2048u * (row >> 3) + 512u * (ch >> 2) + 64u * (row & 7) + 16u * ((ch & 3) ^ ((row >> 2) & 3)); }
constexpr int SC_QT = 0, SC_KT = 8192, SC_VI = 16384, SC_FAC = 24576, SC_EL = SC_FAC + 512, SC_XA = SC_EL + 512, SC_SET = SC_XA + 2560;
constexpr int SC_LF = 2 * SC_SET, SC_END = SC_LF + 2 * 16384;
static_assert(SC_END <= RING_BYTES, "scan LDS");
constexpr int N_SCAN_UNITS = 2 * (BL * NH + BC * NH);

__device__ __forceinline__ void scan_unit(LAS unsigned char* lds, const Ptrs& P, int unit, int tid) {
    unsigned char* ws = P.ws;
    const int wave = __builtin_amdgcn_readfirstlane(tid >> 6), lane = tid & 63, role = wave >> 2, w4 = wave & 3, gt = tid & 255;
    const bool ctx = unit >= 2 * BL * NH;
    int b, h, dir, nch, row0;
    if (ctx) { const int v = unit - 2 * BL * NH; b = v >> 3; h = (v >> 1) & 3; dir = v & 1; nch = TC / 32; row0 = b * TC; } else { b = unit >> 3; h = (unit >> 1) & 3; dir = unit & 1; nch = TL / 32; row0 = NCTX + b * TL; }
    if (role == 0) {
        const unsigned r = lane & 31, h2 = lane >> 5, x = (r >> 2) & 3, blk = (r >> 4) & 1, q4 = (r & 15) >> 2, p = r & 3, pp = p >> 1;
        const unsigned rowb = 2048u * (r >> 3) + 64u * (r & 7);
        const unsigned l15 = lane & 15, b16 = 2048u * (l15 >> 3) + 64u * (l15 & 7) + 16u * ((lane >> 4) ^ ((l15 >> 2) & 3));
        const unsigned bP0 = rowb + 16u * (0u ^ x) + 8u * h2, bP1 = rowb + 16u * (1u ^ x) + 8u * h2, bP2 = rowb + 16u * (2u ^ x) + 8u * h2, bP3 = rowb + 16u * (3u ^ x) + 8u * h2;
        const unsigned z0 = (2u * blk + pp) ^ (2u * h2);
        const unsigned bT0 = 2048u * h2 + 64u * q4 + 8u * (p & 1) + 16u * z0, bT1 = 2048u * h2 + 64u * q4 + 8u * (p & 1) + 16u * (z0 ^ 1u) + 256u;
        float* OP = (float*)(ws + (dir ? WS_MERGED : WS_OTMP)) + h * 128 + 32 * w4 + r;
        f32x16 S[4];
        {
            int ri = r, hi = h2; asm volatile("" : "+v"(ri), "+v"(hi));
            const float* sp = P.state + ((size_t)((b * 2 + dir) * 4 + h) * 128) * 128 + 32 * w4 + ri;
#pragma unroll
            for (int db = 0; db < 4; ++db)
#pragma unroll
                for (int i = 0; i < 16; ++i) S[db][i] = ctx ? 0.f : sp[(size_t)(32 * db + crow(i, hi)) * 128];
        }
        if (gt < 128) ((LAS float*)(lds + SC_SET + SC_EL))[gt] = 1.0f;
        __syncthreads(); __syncthreads(); __syncthreads();
        for (int j = 0; j < nch; ++j) {
            const int chunk = dir ? nch - 1 - j : j;
            LAS unsigned char* Gb = lds + (j & 1) * SC_SET;
            LAS unsigned char* QT = Gb + SC_QT; LAS unsigned char* KT = Gb + SC_KT; LAS unsigned char* VI = Gb + SC_VI + 512 * w4;
            const LAS float* FAC = (const LAS float*)(Gb + SC_FAC) + 4 * h2;
            {
                LAS unsigned char* XA = Gb + SC_XA; const int ti = w4 >> 1, si = w4 & 1;
                f32x4 xt = (f32x4){0.f, 0.f, 0.f, 0.f};
                if (dir == 0 ? !(ti == 0 && si == 1) : !(ti == 1 && si == 0)) {
#pragma unroll
                    for (int ks = 0; ks < 4; ++ks)
                        xt = __builtin_amdgcn_mfma_f32_16x16x32_bf16(*(const LAS bf16x8*)(QT + b16 + 4096 * ti + 512 * ks), *(const LAS bf16x8*)(KT + b16 + 4096 * si + 512 * ks), xt, 0, 0, 0);
                }
                const int tl = 16 * ti + 4 * (int)(lane >> 4), sl = 16 * si + (int)(lane & 15);
#pragma unroll
                for (int e = 0; e < 4; ++e) { const bool keep = dir == 0 ? (sl <= tl + e) : (sl >= tl + e); *(LAS bf16_t*)(XA + (tl + e) * 80 + sl * 2) = f2bf(keep ? xt[e] : 0.f); }
            }
#pragma unroll
            for (int db = 0; db < 4; ++db)
#pragma unroll
                for (int q = 0; q < 4; ++q) { const f32x4 f = *(const LAS f32x4*)(FAC + 32 * db + 8 * q);
#pragma unroll
                    for (int e = 0; e < 4; ++e) S[db][4 * q + e] *= f[e]; }
            __builtin_amdgcn_sched_barrier(0);
            f32x16 O;
#pragma unroll
            for (int i = 0; i < 16; ++i) O[i] = 0.f;
#pragma unroll
            for (int db = 0; db < 4; ++db) {
                const s16x4 l0 = *(const LAS s16x4*)(QT + bP0 + 512 * db), h0 = *(const LAS s16x4*)(QT + bP1 + 512 * db), l1 = *(const LAS s16x4*)(QT + bP2 + 512 * db), h1 = *(const LAS s16x4*)(QT + bP3 + 512 * db);
                O = __builtin_amdgcn_mfma_f32_32x32x16_bf16(cat8(l0, h0), packf8(S[db], 0), O, 0, 0, 0);
                O = __builtin_amdgcn_mfma_f32_32x32x16_bf16(cat8(l1, h1), packf8(S[db], 1), O, 0, 0, 0);
                if (db == 1) __builtin_amdgcn_sched_barrier(0);
            }
            __syncthreads();
#pragma unroll
            for (int s2 = 0; s2 < 2; ++s2) {
                const bf16x8 vb = cat8(ldtr(VI + bT0 + 4096 * s2), ldtr(VI + bT1 + 4096 * s2));
                O = __builtin_amdgcn_mfma_f32_32x32x16_bf16(*(const LAS bf16x8*)(Gb + SC_XA + r * 80 + 32 * s2 + 16 * h2), vb, O, 0, 0, 0);
#pragma unroll
                for (int db = 0; db < 4; ++db)
                    S[db] = __builtin_amdgcn_mfma_f32_32x32x16_bf16(cat8(ldtr(KT + bT0 + 4096 * s2 + 512 * db), ldtr(KT + bT1 + 4096 * s2 + 512 * db)), vb, S[db], 0, 0, 0);
                __builtin_amdgcn_sched_barrier(0);
            }
            {
                float* op = OP + (size_t)(row0 + 32 * chunk + 4 * h2) * 512;
#pragma unroll
                for (int i = 0; i < 16; ++i) op[(size_t)((i & 3) + 8 * (i >> 2)) * 512] = O[i];
            }
            __syncthreads();
        }
        if (ctx) {
            int rf = r, hf = h2; asm volatile("" : "+v"(rf), "+v"(hf));
            const LAS float* ELl = (const LAS float*)(lds + ((nch - 1) & 1) * SC_SET + SC_EL);
            float* ns = P.out + (size_t)M * D + ((size_t)((b * 2 + dir) * 4 + h) * 128) * 128 + 32 * w4 + rf;
#pragma unroll
            for (int db = 0; db < 4; ++db)
#pragma unroll
                for (int i = 0; i < 16; ++i) { const int d = 32 * db + crow(i, hf); ns[(size_t)d * 128] = S[db][i] * ELl[d]; }
        }
    } else {
        const float* LOGF = (const float*)(ws + WS_LOGF) + dir * 512 + h * 128; const bf16_t* KKp = (const bf16_t*)(ws + WS_KK) + dir * 512 + h * 128;
        const bf16_t* Qp = (const bf16_t*)(ws + WS_Q) + h * 128; const bf16_t* Vp = (const bf16_t*)(ws + WS_V) + h * 128;
        const int it = gt >> 4, oct = gt & 15;
        const unsigned io0 = off_a(it, oct), io1 = off_a(it + 16, oct);
        u32x4 q8[2], k8[2], v8[2]; f32x4 lfa[2], lfb[2];
#define SC_LOAD_LF(chunk) do { _Pragma("unroll") for (int ii = 0; ii < 2; ++ii) { const size_t row = (size_t)(row0 + 32 * (chunk) + it + 16 * ii); \
        lfa[ii] = *(const f32x4*)(LOGF + row * 1024 + oct * 8); lfb[ii] = *(const f32x4*)(LOGF + row * 1024 + oct * 8 + 4); } } while (0)
#define SC_LOAD_QKV(chunk) do { _Pragma("unroll") for (int ii = 0; ii < 2; ++ii) { const size_t row = (size_t)(row0 + 32 * (chunk) + it + 16 * ii); \
        q8[ii] = *(const u32x4*)(Qp + row * 512 + oct * 8); k8[ii] = *(const u32x4*)(KKp + row * 1024 + oct * 8); v8[ii] = *(const u32x4*)(Vp + row * 512 + oct * 8); } } while (0)
#define SC_PUT_LF(buf) do { LAS float* L_ = (LAS float*)(lds + SC_LF + (buf) * 16384); _Pragma("unroll") for (int ii = 0; ii < 2; ++ii) { const int t = it + 16 * ii; \
        *(LAS f32x4*)(L_ + t * 128 + oct * 8) = lfa[ii]; *(LAS f32x4*)(L_ + t * 128 + oct * 8 + 4) = lfb[ii]; } } while (0)
        SC_LOAD_LF(dir ? nch - 1 : 0); SC_LOAD_QKV(dir ? nch - 1 : 0);
        SC_PUT_LF(0);
        if (nch > 1) SC_LOAD_LF(dir ? nch - 2 : 1);
        __syncthreads();
        for (int jn = 0; jn < nch; ++jn) {
            LAS unsigned char* Gb = lds + (jn & 1) * SC_SET;
            LAS float* LF = (LAS float*)(lds + SC_LF + (jn & 1) * 16384);
            {
                LAS float* FAC = (LAS float*)(Gb + SC_FAC); LAS float* EL = (LAS float*)(Gb + SC_EL); const LAS float* ELprev = (const LAS float*)(lds + ((jn + 1) & 1) * SC_SET + SC_EL);
                const int d = gt & 127, half = gt >> 7; float acc = 0.f;
                if (half == 0) {
#pragma unroll
                    for (int t = 15; t >= 0; --t) { const float xx = LF[t * 128 + d]; if (dir == 0) { LF[t * 128 + d] = -acc; acc += xx; } else { acc += xx; LF[t * 128 + d] = acc; } }
                    if (dir == 0) FAC[d] = __expf(acc) * ELprev[d]; else EL[d] = __expf(acc);
                } else {
#pragma unroll
                    for (int t = 16; t < 32; ++t) { const float xx = LF[t * 128 + d]; if (dir == 0) { acc += xx; LF[t * 128 + d] = acc; } else { LF[t * 128 + d] = -acc; acc += xx; } }
                    if (dir == 0) EL[d] = __expf(acc); else FAC[d] = __expf(acc) * ELprev[d];
                }
            }
            __syncthreads();
#pragma unroll
            for (int ii = 0; ii < 2; ++ii) { const int t = it + 16 * ii; const unsigned io = ii ? io1 : io0;
                const f32x4 ca = *(const LAS f32x4*)(LF + t * 128 + oct * 8), cb = *(const LAS f32x4*)(LF + t * 128 + oct * 8 + 4);
                float qf[8], kf[8]; unpack8(q8[ii], qf); unpack8(k8[ii], kf);
                const float cc[8] = {ca[0], ca[1], ca[2], ca[3], cb[0], cb[1], cb[2], cb[3]};
#pragma unroll
                for (int e = 0; e < 8; ++e) { const float e1 = __expf(cc[e]), e2 = __expf(-cc[e]); qf[e] *= e1; kf[e] *= e2; }
                *(LAS u32x4*)(Gb + SC_QT + io) = pack8(qf); *(LAS u32x4*)(Gb + SC_KT + io) = pack8(kf); *(LAS u32x4*)(Gb + SC_VI + io) = v8[ii]; }
            if (jn + 1 < nch) {
                SC_PUT_LF((jn + 1) & 1);
                SC_LOAD_QKV(dir ? nch - 2 - jn : jn + 1);
                if (jn + 2 < nch) SC_LOAD_LF(dir ? nch - 3 - jn : jn + 2);
            }
            __syncthreads();
        }
        __syncthreads(); __syncthreads();
#undef SC_LOAD_LF
#undef SC_LOAD_QKV
#undef SC_PUT_LF
    }
    __syncthreads();
}

__device__ __forceinline__ void phase_ofinal(const Ptrs& P, int tid, int G) {
    unsigned char* ws = P.ws; const int gl = blockIdx.x * (NWAVES * 64) + tid, NT = G * NWAVES * 64;
    for (int i = gl; i < M * NH * 8; i += NT) {
        const int row = i >> 5, col = (i & 31) * 16;
        const float* fp = (const float*)(ws + WS_OTMP) + (size_t)row * 512 + col; const float* bp = (const float*)(ws + WS_MERGED) + (size_t)row * 512 + col;
        float o[16]; float ss = 0.f;
#pragma unroll
        for (int q = 0; q < 4; ++q) { const f32x4 a = *(const f32x4*)(fp + 4 * q), c = *(const f32x4*)(bp + 4 * q);
#pragma unroll
            for (int e = 0; e < 4; ++e) { o[4 * q + e] = a[e] + c[e]; ss += o[4 * q + e] * o[4 * q + e]; } }
        ss += __shfl_xor(ss, 1); ss += __shfl_xor(ss, 2); ss += __shfl_xor(ss, 4);
        const float rs = rsqrtf(ss * (1.0f / 128.0f) + EPS);
        const bf16_t* ogp = (const bf16_t*)(ws + WS_OG) + (size_t)row * 512 + col; bf16_t* dst = (bf16_t*)(ws + WS_ACAT) + (size_t)row * 1024 + col;
#pragma unroll
        for (int q = 0; q < 2; ++q) { float og[8], v[8]; unpack8(*(const u32x4*)(ogp + 8 * q), og);
            const f32x4 n0 = *(const f32x4*)(P.hgrn_norm_g + col + 8 * q), n1 = *(const f32x4*)(P.hgrn_norm_g + col + 8 * q + 4);
#pragma unroll
            for (int e = 0; e < 4; ++e) { v[e] = o[8 * q + e] * rs * n0[e] * og[e]; v[4 + e] = o[8 * q + 4 + e] * rs * n1[e] * og[4 + e]; }
            *(u32x4*)(dst + 8 * q) = pack8(v); }
    }
}

__device__ __forceinline__ void pool1d_item(const Ptrs& P, int idx, int lane) {
    unsigned char* ws = P.ws; const bf16_t* Z = (const bf16_t*)(ws + WS_POOL);
    const int g = 3 - (idx / (NCTX / 4)), quad = idx % (NCTX / 4);
    const int m = 4 * quad + (lane >> 4), c = g * 128 + 8 * (lane & 15), w = 2 << g, hw = w >> 1;
    float s[8];
#pragma unroll
    for (int e = 0; e < 8; ++e) s[e] = 0.f;
    const int b = m / TC, pos = m % TC; const bf16_t* zb = Z + (size_t)(b * TC) * DB + c;
    const int lo = pos - hw < 0 ? 0 : pos - hw, hi = pos + hw - 1 > TC - 1 ? TC - 1 : pos + hw - 1, cnt = hi - lo + 1;
#pragma unroll 4
    for (int dt = -hw; dt < hw; ++dt) { const int t = pos + dt, tc = t < 0 ? 0 : (t > TC - 1 ? TC - 1 : t); const float wgt = (t == tc) ? 1.0f : 0.0f;
        float f[8]; unpack8(*(const u32x4*)(zb + (size_t)tc * DB), f);
#pragma unroll
        for (int e = 0; e < 8; ++e) s[e] += wgt * f[e]; }
    float x[8]; unpack8(*(const u32x4*)(Z + (size_t)m * DB + c), x); const float inv = 1.0f / (float)cnt;
#pragma unroll
    for (int e = 0; e < 8; ++e) s[e] = s[e] * inv - x[e];
    *(u32x4*)((bf16_t*)(ws + WS_ACAT) + (size_t)m * 1024 + 512 + c) = pack8(s);
}
constexpr int N_POOL2D = BL * 4 * 8;
__device__ __forceinline__ void pool2d_item(LAS unsigned char* lds, const Ptrs& P, int item, int tid) {
    unsigned char* ws = P.ws; const bf16_t* Z = (const bf16_t*)(ws + WS_POOL);
    const int g = 3 - (item >> 4), b = (item >> 3) & 1, c0 = g * 128 + (item & 7) * 16, w = 2 << g, hw = w >> 1;
    LAS unsigned char* XL = lds;
    LAS float* HL = (LAS float*)(lds + 32768);
    const size_t rbase = (size_t)(NCTX + b * TL);
    u32x4 xv[4];
#pragma unroll
    for (int k = 0; k < 4; ++k) { const int i = tid + 512 * k, tok = i >> 1, half = i & 1; xv[k] = *(const u32x4*)(Z + (rbase + tok) * DB + c0 + half * 8); *(LAS u32x4*)(XL + i * 16) = xv[k]; }
    __syncthreads();
#pragma unroll
    for (int k = 0; k < 4; ++k) { const int i = tid + 512 * k, tok = i >> 1, half = i & 1, gc = tok & 63;
        const int clo = gc - hw < 0 ? 0 : gc - hw, chi = gc + hw - 1 > GRID_W - 1 ? GRID_W - 1 : gc + hw - 1;
        float s[8];
#pragma unroll
        for (int e = 0; e < 8; ++e) s[e] = 0.f;
        for (int cc = clo; cc <= chi; ++cc) { float f[8]; unpack8(*(const LAS u32x4*)(XL + (((tok & ~63) + cc) * 2 + half) * 16), f);
#pragma unroll
            for (int e = 0; e < 8; ++e) s[e] += f[e]; }
        *(LAS f32x4*)(HL + i * 8) = (f32x4){s[0], s[1], s[2], s[3]}; *(LAS f32x4*)(HL + i * 8 + 4) = (f32x4){s[4], s[5], s[6], s[7]}; }
    __syncthreads();
#pragma unroll
    for (int k = 0; k < 4; ++k) { const int i = tid + 512 * k, tok = i >> 1, half = i & 1, gr = tok >> 6, gc = tok & 63;
        const int rlo = gr - hw < 0 ? 0 : gr - hw, rhi = gr + hw - 1 > GRID_H - 1 ? GRID_H - 1 : gr + hw - 1, clo = gc - hw < 0 ? 0 : gc - hw, chi = gc + hw - 1 > GRID_W - 1 ? GRID_W - 1 : gc + hw - 1;
        float s[8];
#pragma unroll
        for (int e = 0; e < 8; ++e) s[e] = 0.f;
        for (int rr = rlo; rr <= rhi; ++rr) { const LAS float* hp = HL + ((rr * 64 + gc) * 2 + half) * 8; const f32x4 a = *(const LAS f32x4*)hp, c = *(const LAS f32x4*)(hp + 4);
#pragma unroll
            for (int e = 0; e < 4; ++e) { s[e] += a[e]; s[4 + e] += c[e]; } }
        float x[8]; unpack8(xv[k], x); const float inv = 1.0f / (float)((rhi - rlo + 1) * (chi - clo + 1));
#pragma unroll
        for (int e = 0; e < 8; ++e) s[e] = s[e] * inv - x[e];
        *(u32x4*)((bf16_t*)(ws + WS_ACAT) + (rbase + tok) * 1024 + 512 + c0 + half * 8) = pack8(s); }
    __syncthreads();
}
constexpr int NGATE_ = 2 * D;
__device__ __forceinline__ void gate_units(LAS unsigned char* lds, const Ptrs& P, int ng, int c) {
    unsigned char* ws = P.ws;
    int tid; { int l_; asm volatile("v_mbcnt_lo_u32_b32 %0, -1, 0\n\tv_mbcnt_hi_u32_b32 %0, -1, %0" : "=v"(l_)); int w_ = __builtin_amdgcn_readfirstlane((int)threadIdx.x >> 6); asm volatile("" : "+s"(w_)); tid = w_ * 64 + l_; }
    const pg8::Gemm gg{(const bf16_t*)(ws + WS_H1), (const bf16_t*)(ws + WS_WIN) + (size_t)(INC - NGATE_) * D, M, NGATE_, D};
    const EpiG1 EG{ws, P.lb_logits, (INC - NGATE_) / 256};
    pg8::StaticOrder S; S.init(M, NGATE_, ng, c);
    pg8::gemm_phase<EpiG1, pg8::StaticOrder, true, true>(lds, gg, S, EG, tid);
}
constexpr int NGATE = 2 * D;
__device__ __forceinline__ void phase_mixers(LAS unsigned char* lds, const Ptrs& P, int tid, int G) {
    unsigned char* ws = P.ws;
    const int bid = blockIdx.x;
    constexpr int NLONG = 2 * BL * NH;
#ifndef PROBE_SCAN
#define PROBE_SCAN 1
#endif
#ifndef PROBE_POOL
#define PROBE_POOL 1
#endif
    const int u2 = G + (bid - NLONG), nu = (bid >= NLONG && u2 < N_SCAN_UNITS) ? 2 : 1;
    for (int rp = 0; rp < PROBE_SCAN; ++rp)
        for (int k = 0; k < nu; ++k) scan_unit(lds, P, k == 0 ? bid : u2, tid);
    if (bid >= NLONG) {
        int tid2 = tid; asm volatile("" : "+v"(tid2));
        const int wave = __builtin_amdgcn_readfirstlane(tid2 >> 6), lane = tid2 & 63;
        for (int rp = 0; rp < PROBE_POOL; ++rp) {
            const int nb2 = G - 2 * NLONG;
            if (bid >= 2 * NLONG) for (int it2 = bid - 2 * NLONG; it2 < N_POOL2D; it2 += nb2) pool2d_item(lds, P, it2, tid2);
            const int npb = G - NLONG, npw = npb * NWAVES; for (int idx = wave * npb + (bid - NLONG); idx < NCTX; idx += npw) pool1d_item(P, idx, lane);
            for (int it = WI_IN + wave * npb + (bid - NLONG); it < WI_AB; it += npw) wcopy_item(P, (LAS float*)(lds + wave * 16384), lane, it);
        }
        __syncthreads();
        gate_units(lds, P, G - NLONG, bid - NLONG);
    }
}
struct Args { Ptrs P; int ph_lo, ph_hi; };

__global__ void __launch_bounds__(NWAVES * 64, 2) mega(Args a) {
    extern __shared__ __attribute__((aligned(16))) unsigned char lds_raw[];
    LAS unsigned char* lds = (LAS unsigned char*)lds_raw;
    const Ptrs& P = a.P; unsigned char* ws = P.ws;
    const int wave_s = __builtin_amdgcn_readfirstlane((int)threadIdx.x >> 6), G = gridDim.x;
#define FRESH_TID() int tid; { int l_; asm volatile("v_mbcnt_lo_u32_b32 %0, -1, 0\n\tv_mbcnt_hi_u32_b32 %0, -1, %0" : "=v"(l_)); tid = wave_s * 64 + l_; }
    { FRESH_TID(); for (int i = tid; i < (LDS_BYTES - LDSCTL_OFF) / 4; i += NWAVES * 64) ((LAS unsigned*)(lds + LDSCTL_OFF))[i] = 0u; }
    __syncthreads();
    const int lo = a.ph_lo, hi = a.ph_hi;
    XcdBarrier bar; bar.bar = (unsigned*)(ws + WS_CTL) + CW_BAR; bar.x = 0; bar.st = nullptr; bar.leader = false;
    if (hi - lo > 1) { FRESH_TID(); bar = xcd_barrier_post((unsigned*)(ws + WS_CTL) + CW_BAR, (volatile LAS unsigned*)(lds + MISC_OFF) + 8, tid); }
#ifndef PHASE_MASK
#define PHASE_MASK 0x3FF
#endif
#define IN(k) ((((PHASE_MASK) >> (k)) & 1) && lo <= (k) && (k) < hi)
#define BOTH(k) (IN(k) && IN((k) + 1))
#ifndef REP_MASK
#define REP_MASK 0
#endif
#ifndef BAR_REP
#define BAR_REP 1
#endif
#define GRID_BAR() do { for (int br_ = 0; br_ < BAR_REP; ++br_) xcd_barrier(bar); } while (0)
#define REPS(k) for (int rep_ = 0; rep_ < 1 + (((REP_MASK) >> (k)) & 1); ++rep_)

    if (IN(0)) { FRESH_TID(); REPS(0) phase_p0a(lds, P, tid, G); if (BOTH(0)) GRID_BAR(); }
    if (IN(1)) { FRESH_TID(); REPS(1) { phase_p0b(lds, P, tid, G); __syncthreads(); } if (BOTH(1)) GRID_BAR(); }
    if (IN(2)) {
        pg8::Gemm g{(const bf16_t*)(ws + WS_H1), (const bf16_t*)(ws + WS_WIN), M, INC - NGATE, D}; pg8::StaticOrder S; S.init(M, INC - NGATE, G, (int)blockIdx.x);
        EpiG1 E{ws, P.lb_logits, 0};
        { FRESH_TID(); REPS(2) pg8::gemm_phase<EpiG1, pg8::StaticOrder, true, true>(lds, g, S, E, tid); }
        if (BOTH(2)) GRID_BAR();
    }
    if (IN(3)) { FRESH_TID(); REPS(3) phase_mixers(lds, P, tid, G); if (BOTH(3)) GRID_BAR(); }
    if (IN(4)) { FRESH_TID(); REPS(4) phase_ofinal(P, tid, G); if (BOTH(4)) GRID_BAR(); }
    if (IN(5)) {
        pg8::Gemm g{(const bf16_t*)(ws + WS_ACAT), (const bf16_t*)(ws + WS_WCAT), M, D, 1024}; pg8::StaticOrder S; S.init(M, D, G, (int)blockIdx.x);
        EpiMerge E{ws};
        { FRESH_TID(); const int nun = (M / 256) * (D / 256), bid = (int)blockIdx.x, wv = tid >> 6, ln = tid & 63;
          if (G > nun) { if (bid >= nun) for (int it = WI_AB + (bid - nun) * NWAVES + wv; it < WI_ALL; it += (G - nun) * NWAVES) wcopy_item(P, (LAS float*)(lds + wv * 16384), ln, it); }
          else { for (int it = WI_AB + bid * NWAVES + wv; it < WI_ALL; it += G * NWAVES) wcopy_item(P, (LAS float*)(lds + wv * 16384), ln, it); __syncthreads(); } }
        { FRESH_TID(); REPS(5) pg8::gemm_phase<EpiMerge, pg8::StaticOrder, false, true>(lds, g, S, E, tid); }
        if (BOTH(5)) GRID_BAR();
    }
    if (IN(6)) {
        pg8::Gemm g{(const bf16_t*)(ws + WS_MERGED), (const bf16_t*)(ws + WS_WOUT), M, D, D}; pg8::StaticOrder S; S.init(M, D, G, (int)blockIdx.x);
        EpiWout E{P};
        { FRESH_TID(); const int nun = (M / 256) * (D / 256), bid = (int)blockIdx.x, wv = tid >> 6;
          if (G > nun) { if (bid >= nun) bias2_rows(lds, P, tid, (bid - nun) * NWAVES + wv, (G - nun) * NWAVES); }
          else bias2_rows(lds, P, tid, bid * NWAVES + wv, G * NWAVES); }
        { FRESH_TID(); REPS(6) pg8::gemm_phase<EpiWout, pg8::StaticOrder, false, true>(lds, g, S, E, tid); }
        if (BOTH(6)) GRID_BAR();
    }
    if (IN(7)) {
        pg8::Gemm g{(const bf16_t*)(ws + WS_A2), (const bf16_t*)(ws + WS_WFFI), M, NFF2, D}; pg8::StaticOrder S; S.init(M, NFF2, G, (int)blockIdx.x);
        EpiFfnIn E{ws};
        { FRESH_TID(); REPS(7) pg8::gemm_phase<EpiFfnIn, pg8::StaticOrder, true, true>(lds, g, S, E, tid); }
        if (BOTH(7)) GRID_BAR();
    }
    if (IN(8)) {
        pg8::Gemm g{(const bf16_t*)(ws + WS_ACT), (const bf16_t*)(ws + WS_WFFO), M, D, DFF}; pg8::StaticOrder S; S.init(M, D, G, (int)blockIdx.x);
        EpiFfnOut E{P};
        { FRESH_TID(); REPS(8) pg8::gemm_phase<EpiFfnOut, pg8::StaticOrder, false, true>(lds, g, S, E, tid); }
        if (BOTH(8)) GRID_BAR();
    }
    if (IN(9)) { FRESH_TID(); phase_final(P, tid, G); }
#undef IN
#undef BOTH
}

#ifndef FAST_MASK
#define FAST_MASK 0x3FF
#endif
#ifndef MAX_FUSE
#define MAX_FUSE 10
#endif
extern "C" void kernel_launch(void* const* d_in, const int* in_sizes, int n_in, void* d_out, int out_size, void* d_ws, size_t ws_size, hipStream_t stream) {
    static int grid = 0;
    if (grid == 0) {
        if (n_in != 20 || ws_size < WS_END || in_sizes[0] != NCTX * D || out_size != M * D + BC * 2 * NH * HD * HD) { fprintf(stderr, "kernel_launch: unexpected shapes (n_in %d, ws %zu); nothing launched\n", n_in, ws_size); grid = -1; return; }
        int dev = 0, cus = 0, per_cu = 0;
        if (hipGetDevice(&dev) != hipSuccess || hipDeviceGetAttribute(&cus, hipDeviceAttributeMultiprocessorCount, dev) != hipSuccess) { grid = -1; return; }
        if (hipFuncSetAttribute((const void*)mega, hipFuncAttributeMaxDynamicSharedMemorySize, LDS_BYTES) != hipSuccess) { fprintf(stderr, "kernel_launch: hipFuncSetAttribute failed\n"); grid = -1; return; }
        if (hipOccupancyMaxActiveBlocksPerMultiprocessor(&per_cu, (const void*)mega, NWAVES * 64, LDS_BYTES) != hipSuccess || per_cu < 1) { fprintf(stderr, "kernel_launch: occupancy query says %d blocks per CU\n", per_cu); per_cu = 1; }
        (void)hipGetLastError();
        if (cus < 256) { fprintf(stderr, "kernel_launch: built for a 256-CU device (found %d CUs); nothing launched\n", cus); grid = -1; return; }
        grid = 256;
    }
    if (grid < 0) return;
    Ptrs P{};
    const float** pp = (const float**)&P;
    for (int i = 0; i < 20; ++i) pp[i] = (const float*)d_in[i];
    P.out = (float*)d_out; P.ws = (unsigned char*)d_ws;
    unsigned char* ws = P.ws;
    auto nb = [](size_t n, int t) { return (unsigned)((n + t - 1) / t); };
    (void)hipMemsetAsync(ws + WS_CTL, 0, CTL_ZERO_BYTES, stream);
    float* ofwd = (float*)(ws + WS_OTMP); float* obwd = (float*)(ws + WS_MERGED);
    int k = 0;
    while (k < N_PHASES) {
        if ((FAST_MASK >> k) & 1) {
            int e = k; while (e < N_PHASES && ((FAST_MASK >> e) & 1) && e - k < MAX_FUSE) ++e;
            Args a{}; a.P = P; a.ph_lo = k; a.ph_hi = e;
            hipLaunchKernelGGL(mega, dim3(grid), dim3(NWAVES * 64), LDS_BYTES, stream, a);
            k = e; continue;
        }
        switch (k) {
        case 0:
            ks_mod<<<nb(3 * MODW, 256), 256, 0, stream>>>(P);
            ks_convT<<<nb((size_t)D * INC, 256), 256, 0, stream>>>(P.w_in, D, INC, (bf16_t*)(ws + WS_WIN), D, 0, 0);
            ks_convT<<<nb((size_t)DA * D, 256), 256, 0, stream>>>(P.w_branch_a, DA, D, (bf16_t*)(ws + WS_WCAT), 1024, 0, 0);
            ks_wpb<<<nb((size_t)DB * D, 256), 256, 0, stream>>>(P);
            ks_convT<<<nb((size_t)D * D, 256), 256, 0, stream>>>(P.w_out, D, D, (bf16_t*)(ws + WS_WOUT), D, 0, 0);
            ks_convT<<<nb((size_t)D * NFF2, 256), 256, 0, stream>>>(P.w_ffn_in, D, NFF2, (bf16_t*)(ws + WS_WFFI), D, 0, 1);
            ks_convT<<<nb((size_t)DFF * D, 256), 256, 0, stream>>>(P.w_ffn_out, DFF, D, (bf16_t*)(ws + WS_WFFO), DFF, 0, 0);
            break;
        case 1:
            ks_h1<<<nb((size_t)M * 64, 256), 256, 0, stream>>>(P);
            ks_bias2<<<nb(3 * NFF2, 256), 256, 0, stream>>>(P);
            break;
        case 2:
            ks_gemm<EpiG1s><<<nb((size_t)(M / 32) * (INC / 32) * 64, 256), 256, 0, stream>>>((const bf16_t*)(ws + WS_H1), D, (const bf16_t*)(ws + WS_WIN), D, D, M, INC, EpiG1s{ws, P.lb_logits});
            break;
        case 3:
            ks_scan<<<BC * NH * 2 + BL * NH * 2, 128, 0, stream>>>(P, ofwd, obwd);
            ks_pool<<<nb((size_t)M * DB, 256), 256, 0, stream>>>(P);
            break;
        case 4:
            ks_ofinal<<<nb((size_t)M * NH * 64, 256), 256, 0, stream>>>(P, ofwd, obwd);
            break;
        case 5:
            ks_gemm<EpiMerges><<<nb((size_t)(M / 32) * (D / 32) * 64, 256), 256, 0, stream>>>((const bf16_t*)(ws + WS_ACAT), 1024, (const bf16_t*)(ws + WS_WCAT), 1024, 512, M, D, EpiMerges{ws});
            break;
        case 6:
            ks_gemm<EpiWouts><<<nb((size_t)(M / 32) * (D / 32) * 64, 256), 256, 0, stream>>>((const bf16_t*)(ws + WS_MERGED), 1024, (const bf16_t*)(ws + WS_WOUT), 1024, D, M, D, EpiWouts{P});
            ks_ss2<<<nb((size_t)M * 16, 256), 256, 0, stream>>>(P);
            break;
        case 7:
            ks_gemm<EpiFfnIns><<<nb((size_t)(M / 32) * (DFF / 32) * 64, 256), 256, 0, stream>>>((const bf16_t*)(ws + WS_A2), 1024, (const bf16_t*)(ws + WS_WFFI), 1024, D, M, DFF, EpiFfnIns{ws});
            break;
        case 8:
            ks_gemm<EpiFfnOuts><<<nb((size_t)(M / 32) * (D / 32) * 64, 256), 256, 0, stream>>>((const bf16_t*)(ws + WS_ACT), DFF, (const bf16_t*)(ws + WS_WFFO), DFF, DFF, M, D, EpiFfnOuts{P});
            break;
        case 9:
            ks_final<<<nb((size_t)M * 64, 256), 256, 0, stream>>>(P);
            break;
        }
        ++k;
    }
}
```
